# Optimizing an MI355X kernel written in HIP

```python
import math
import jax, jax.numpy as jnp
from jax import lax
import numpy as np

D_MODEL = 1024
BATCH = 4
SEQ = 4096
DEPTH = 2

CHUNK = 64
HEAD_DIM = 64
D_POOL = D_MODEL // 4
POOL_WINDOWS = (2, 4, 8, 16)
N_POOL_GROUPS = len(POOL_WINDOWS)
POOL_GROUP = D_POOL // N_POOL_GROUPS
D_CHUNK = 3 * D_MODEL // 8
N_CHUNK_HEADS = D_CHUNK // HEAD_DIM
LEFT_CHUNKS = 8
BAND = (LEFT_CHUNKS + 1) * CHUNK
REL_CLIP = 128
D_SB = D_MODEL - D_POOL - D_CHUNK
N_SB_HEADS = D_SB // HEAD_DIM
SB_BLOCK = 128
D_IN = D_POOL + 3 * D_CHUNK + 3 * D_SB
D_FF = ((8 * D_MODEL // 3 + 127) // 128) * 128
N_EXPERTS = 8
TOP_K = 2
D_FF_EXPERT = D_FF
N_DENSE = (DEPTH + 1) // 2
N_MOE = DEPTH // 2
ALPHA = (2.0 * DEPTH) ** 0.25
BETA = (8.0 * DEPTH) ** -0.25
LN_EPS = 1e-5
RMS_EPS = 1e-6
NEG_INF = -1e30

kernel_name = "hybrid_pool_chunkattn_stickbreak_moe_deepnorm"


def layer_norm(x, g, b):
    xf = x.astype(jnp.float32)
    mu = jnp.mean(xf, axis=-1, keepdims=True)
    xc = xf - mu
    var = jnp.mean(xc * xc, axis=-1, keepdims=True)
    y = xc * lax.rsqrt(var + LN_EPS) * g.astype(jnp.float32) + b.astype(jnp.float32)
    return y.astype(x.dtype)


def rms_normalise(y):
    yf = y.astype(jnp.float32)
    return yf * lax.rsqrt(jnp.mean(yf * yf, axis=-1, keepdims=True) + RMS_EPS)


def pool_mixer(u, pool_w, pool_scale):
    B, S, _ = u.shape
    uf = u.astype(jnp.float32)
    cs = jnp.cumsum(uf, axis=1)
    t = jnp.arange(S, dtype=jnp.float32)[None, :, None]
    outs = []
    for g, w in enumerate(POOL_WINDOWS):
        c = cs[..., g * POOL_GROUP:(g + 1) * POOL_GROUP]
        lag = jnp.pad(c[:, :-w], ((0, 0), (w, 0), (0, 0)))
        cnt = jnp.minimum(t + 1.0, float(w))
        outs.append((c - lag) / cnt)
    pooled = jnp.concatenate(outs, axis=-1) - uf
    pooled = pooled.reshape(B, S, N_POOL_GROUPS, POOL_GROUP)
    y = jnp.einsum('bsgc,gcd->bsgd', pooled, pool_w.astype(jnp.float32))
    return y.reshape(B, S, D_POOL) * pool_scale.astype(jnp.float32)


def chunk_attention(q, k, v, rel_bias):
    B, S, H, d = q.shape
    nc = S // CHUNK
    qc = q.reshape(B, nc, CHUNK, H, d).astype(jnp.float32)
    pad = ((0, 0), (LEFT_CHUNKS, 0), (0, 0), (0, 0), (0, 0))
    kc = jnp.pad(k.reshape(B, nc, CHUNK, H, d).astype(jnp.float32), pad)
    vc = jnp.pad(v.reshape(B, nc, CHUNK, H, d).astype(jnp.float32), pad)
    kband = jnp.concatenate([kc[:, j:j + nc] for j in range(LEFT_CHUNKS + 1)], axis=2)
    vband = jnp.concatenate([vc[:, j:j + nc] for j in range(LEFT_CHUNKS + 1)], axis=2)
    scores = jnp.einsum('bnqhd,bnkhd->bhnqk', qc, kband) * (1.0 / math.sqrt(d))
    qi = jnp.arange(CHUNK)[:, None]
    kj = jnp.arange(BAND)[None, :]
    rel = jnp.clip(qi + LEFT_CHUNKS * CHUNK - kj, -REL_CLIP, REL_CLIP) + REL_CLIP
    bias = rel_bias.astype(jnp.float32)[:, rel]
    key_chunk = jnp.arange(nc)[:, None] - LEFT_CHUNKS + jnp.arange(BAND)[None, :] // CHUNK
    valid = key_chunk >= 0
    scores = scores + bias[None, :, None, :, :]
    scores = jnp.where(valid[None, None, :, None, :], scores, NEG_INF)
    p = jax.nn.softmax(scores, axis=-1)
    o = jnp.einsum('bhnqk,bnkhd->bnqhd', p, vband)
    return o.reshape(B, S, H * d)


def stick_breaking_attention(q, k, v):
    B, S, H, d = q.shape
    qh = q.transpose(0, 2, 1, 3).astype(jnp.float32)
    kh = k.transpose(0, 2, 1, 3).astype(jnp.float32)
    vh = v.transpose(0, 2, 1, 3).astype(jnp.float32)
    scale = 1.0 / math.sqrt(d)
    outs = []
    for blk in range(S // SB_BLOCK):
        lo = blk * SB_BLOCK
        hi = lo + SB_BLOCK
        z = jnp.einsum('bhqd,bhkd->bhqk', qh[:, :, lo:hi], kh[:, :, :hi]) * scale
        t = lo + jnp.arange(SB_BLOCK)[:, None]
        s = jnp.arange(hi)[None, :]
        before = s < t
        log_keep = jnp.where(before, jax.nn.log_sigmoid(-z), 0.0)
        suffix = lax.cumsum(log_keep, axis=3, reverse=True) - log_keep
        w = jnp.where(before, jnp.exp(jax.nn.log_sigmoid(z) + suffix), 0.0)
        outs.append(jnp.einsum('bhqk,bhkd->bhqd', w, vh[:, :, :hi]))
    o = jnp.concatenate(outs, axis=2)
    return o.transpose(0, 2, 1, 3).reshape(B, S, H * d)


def hybrid_mixer(x, w_in, pool_w, pool_scale, rel_bias, g_mix, w_out):
    B, S, _ = x.shape
    h = x @ w_in
    u_pool = h[..., :D_POOL]
    qkv_c = h[..., D_POOL:D_POOL + 3 * D_CHUNK]
    qkv_s = h[..., D_POOL + 3 * D_CHUNK:]
    y_pool = pool_mixer(u_pool, pool_w, pool_scale)
    qc, kc, vc = [a.reshape(B, S, N_CHUNK_HEADS, HEAD_DIM) for a in jnp.split(qkv_c, 3, axis=-1)]
    y_chunk = chunk_attention(qc, kc, vc, rel_bias)
    qs, ks, vs = [a.reshape(B, S, N_SB_HEADS, HEAD_DIM) for a in jnp.split(qkv_s, 3, axis=-1)]
    y_sb = stick_breaking_attention(qs, ks, vs)
    y = jnp.concatenate([rms_normalise(y_pool), rms_normalise(y_chunk), rms_normalise(y_sb)], axis=-1)
    y = (y * g_mix.astype(jnp.float32)).astype(x.dtype)
    return y @ w_out


def swiglu(x, wg, wu, wd):
    return (jax.nn.silu(x @ wg) * (x @ wu)) @ wd


def moe_swiglu(x, router, wg, wu, wd):
    B, S, D = x.shape
    xt = x.reshape(B * S, D)
    logits = (xt @ router).astype(jnp.float32)
    top_val, top_idx = lax.top_k(logits, TOP_K)
    top_w = jax.nn.softmax(top_val, axis=-1)
    gates = jnp.sum(jax.nn.one_hot(top_idx, N_EXPERTS, dtype=jnp.float32) * top_w[..., None], axis=1)
    out = jnp.zeros((B * S, D), jnp.float32)
    for e in range(N_EXPERTS):
        out = out + gates[:, e:e + 1] * swiglu(xt, wg[e], wu[e], wd[e]).astype(jnp.float32)
    return out.reshape(B, S, D).astype(x.dtype)


def setup_inputs(seed: int = 0) -> dict:
    key = jax.random.key(seed)
    ks = jax.random.split(key, 20)
    f32 = jnp.float32
    n = lambda k, shape, s: jax.random.normal(k, shape, f32) * s
    x = jax.random.normal(ks[0], (BATCH, SEQ, D_MODEL), f32)
    w_in = n(ks[1], (DEPTH, D_MODEL, D_IN), D_MODEL ** -0.5)
    pool_w = n(ks[2], (DEPTH, N_POOL_GROUPS, POOL_GROUP, POOL_GROUP), POOL_GROUP ** -0.5)
    pool_scale = 1.0 + n(ks[3], (DEPTH, D_POOL), 0.05)
    rel_bias = n(ks[4], (DEPTH, N_CHUNK_HEADS, 2 * REL_CLIP + 1), 0.3)
    g_mix = 1.0 + n(ks[5], (DEPTH, D_MODEL), 0.05)
    w_out = n(ks[6], (DEPTH, D_MODEL, D_MODEL), BETA * D_MODEL ** -0.5)
    ln1_g = 1.0 + n(ks[7], (DEPTH, D_MODEL), 0.05)
    ln1_b = n(ks[8], (DEPTH, D_MODEL), 0.02)
    ln2_g = 1.0 + n(ks[9], (DEPTH, D_MODEL), 0.05)
    ln2_b = n(ks[10], (DEPTH, D_MODEL), 0.02)
    ffn_wg = n(ks[11], (N_DENSE, D_MODEL, D_FF), D_MODEL ** -0.5)
    ffn_wu = n(ks[12], (N_DENSE, D_MODEL, D_FF), D_MODEL ** -0.5)
    ffn_wd = n(ks[13], (N_DENSE, D_FF, D_MODEL), BETA * D_FF ** -0.5)
    moe_router = n(ks[14], (N_MOE, D_MODEL, N_EXPERTS), D_MODEL ** -0.5)
    moe_wg = n(ks[15], (N_MOE, N_EXPERTS, D_MODEL, D_FF_EXPERT), D_MODEL ** -0.5)
    moe_wu = n(ks[16], (N_MOE, N_EXPERTS, D_MODEL, D_FF_EXPERT), D_MODEL ** -0.5)
    moe_wd = n(ks[17], (N_MOE, N_EXPERTS, D_FF_EXPERT, D_MODEL), BETA * D_FF_EXPERT ** -0.5)
    return {"x": x, "w_in": w_in, "pool_w": pool_w, "pool_scale": pool_scale, "rel_bias": rel_bias,
            "g_mix": g_mix, "w_out": w_out, "ln1_g": ln1_g, "ln1_b": ln1_b, "ln2_g": ln2_g, "ln2_b": ln2_b,
            "ffn_wg": ffn_wg, "ffn_wu": ffn_wu, "ffn_wd": ffn_wd, "moe_router": moe_router,
            "moe_wg": moe_wg, "moe_wu": moe_wu, "moe_wd": moe_wd}


def reference(x, w_in, pool_w, pool_scale, rel_bias, g_mix, w_out, ln1_g, ln1_b, ln2_g, ln2_b,
              ffn_wg, ffn_wu, ffn_wd, moe_router, moe_wg, moe_wu, moe_wd):
    for i in range(DEPTH):
        m = hybrid_mixer(x, w_in[i], pool_w[i], pool_scale[i], rel_bias[i], g_mix[i], w_out[i])
        x = layer_norm(ALPHA * x + m, ln1_g[i], ln1_b[i])
        j = i // 2
        if i % 2 == 0:
            f = swiglu(x, ffn_wg[j], ffn_wu[j], ffn_wd[j])
        else:
            f = moe_swiglu(x, moe_router[j], moe_wg[j], moe_wu[j], moe_wd[j])
        x = layer_norm(ALPHA * x + f, ln2_g[i], ln2_b[i])
    return x
```

```cpp
#include <hip/hip_runtime.h>
#include <stdint.h>
#include <math.h>

typedef unsigned short bf16_t;
typedef short bf16x8 __attribute__((ext_vector_type(8)));
typedef float f32x4 __attribute__((ext_vector_type(4)));

constexpr int D = 1024, BATCH = 4, SEQ = 4096, M = BATCH * SEQ;
constexpr int DIN = 2560, DFF = 2816, NEXP = 8;
constexpr int C_POOL = 0, C_QC = 256, C_KC = 640, C_VC = 1024, C_QS = 1408, C_KS = 1792, C_VS = 2176;
constexpr float ALPHA = 1.4142135623730951f, LN_EPS = 1e-5f, RMS_EPS = 1e-6f;

__device__ __forceinline__ unsigned short f2bf(float f) { unsigned u = __float_as_uint(f); u += 0x7fffu + ((u >> 16) & 1u); return (unsigned short)(u >> 16); }
__device__ __forceinline__ float bf2f(unsigned short h) { return __uint_as_float(((unsigned)h) << 16); }
__device__ __forceinline__ float wave_sum(float v) {
#pragma unroll
    for (int o = 1; o < 64; o <<= 1) v += __shfl_xor(v, o);
    return v;
}
__device__ __forceinline__ float wave_max(float v) {
#pragma unroll
    for (int o = 1; o < 64; o <<= 1) v = fmaxf(v, __shfl_xor(v, o));
    return v;
}

struct EpiStoreBf16 { bf16_t* O; int ldc; int pad; __device__ void operator()(int r, int c, float v, float) const { O[(size_t)r * ldc + c] = f2bf(v); } };
struct EpiStoreF32 { float* O; int ldc; int pad; __device__ void operator()(int r, int c, float v, float) const { O[(size_t)r * ldc + c] = v; } };
struct EpiSwiglu { bf16_t* O; int ldc; int pad; __device__ void operator()(int r, int c, float g, float u) const { O[(size_t)r * ldc + c] = f2bf(g / (1.f + expf(-g)) * u); } };
struct EpiMoeAcc { float* O; const float* gates; int e; int pad; __device__ void operator()(int r, int c, float v, float) const {
    float* p = O + (size_t)r * D + c; const float prev = e == 0 ? 0.f : *p; *p = prev + gates[r * NEXP + e] * v; } };

template <bool DUAL, class Epi>
__global__ __launch_bounds__(256) void gemm_simple(const bf16_t* __restrict__ A, int lda, const float* __restrict__ B, const float* __restrict__ B2, int ldb, int K, Epi epi) {
    const int lane = threadIdx.x & 63, wid = threadIdx.x >> 6;
    const int m0 = blockIdx.y * 128 + (wid >> 1) * 64, n0 = blockIdx.x * 128 + (wid & 1) * 64;
    const int r = lane & 15, q = lane >> 4;
    f32x4 acc[4][4], acc2[4][4];
#pragma unroll
    for (int i = 0; i < 4; ++i)
#pragma unroll
        for (int j = 0; j < 4; ++j) { acc[i][j] = (f32x4){0.f, 0.f, 0.f, 0.f}; acc2[i][j] = (f32x4){0.f, 0.f, 0.f, 0.f}; }
    for (int k0 = 0; k0 < K; k0 += 32) {
        bf16x8 a[4], b[4], b2[4];
#pragma unroll
        for (int mi = 0; mi < 4; ++mi) a[mi] = *(const bf16x8*)(A + (size_t)(m0 + 16 * mi + r) * lda + k0 + 8 * q);
#pragma unroll
        for (int ni = 0; ni < 4; ++ni)
#pragma unroll
            for (int j = 0; j < 8; ++j) {
                const size_t off = (size_t)(k0 + 8 * q + j) * ldb + n0 + 16 * ni + r;
                b[ni][j] = (short)f2bf(B[off]);
                if (DUAL) b2[ni][j] = (short)f2bf(B2[off]);
            }
#pragma unroll
        for (int mi = 0; mi < 4; ++mi)
#pragma unroll
            for (int ni = 0; ni < 4; ++ni) {
                acc[mi][ni] = __builtin_amdgcn_mfma_f32_16x16x32_bf16(a[mi], b[ni], acc[mi][ni], 0, 0, 0);
                if (DUAL) acc2[mi][ni] = __builtin_amdgcn_mfma_f32_16x16x32_bf16(a[mi], b2[ni], acc2[mi][ni], 0, 0, 0);
            }
    }
#pragma unroll
    for (int mi = 0; mi < 4; ++mi)
#pragma unroll
        for (int ni = 0; ni < 4; ++ni)
#pragma unroll
            for (int i = 0; i < 4; ++i) epi(m0 + 16 * mi + 4 * q + i, n0 + 16 * ni + r, acc[mi][ni][i], DUAL ? acc2[mi][ni][i] : 0.f);
}

__global__ void cvt_x(const float* __restrict__ x, bf16_t* __restrict__ xb, int n) {
    const int i = blockIdx.x * blockDim.x + threadIdx.x; if (i < n) xb[i] = f2bf(x[i]);
}
__global__ void pool_a(const bf16_t* __restrict__ H, float* __restrict__ pooled) {
    const int i = blockIdx.x * blockDim.x + threadIdx.x; if (i >= M * 256) return;
    const int tg = i >> 8, c = i & 255, t = tg & (SEQ - 1), g = c >> 6, w = 2 << g;
    float s = 0.f;
    for (int k = 0; k < w; ++k) if (t - k >= 0) s += bf2f(H[(size_t)(tg - k) * DIN + c]);
    const float cnt = (float)(t + 1 < w ? t + 1 : w);
    pooled[i] = s / cnt - bf2f(H[(size_t)tg * DIN + c]);
}
__global__ void pool_b(const float* __restrict__ pooled, const float* __restrict__ pw, const float* __restrict__ ps, float* __restrict__ Yraw) {
    const int i = blockIdx.x * blockDim.x + threadIdx.x; if (i >= M * 256) return;
    const int tg = i >> 8, dd = i & 255, g = dd >> 6, d = dd & 63;
    float a = 0.f;
    for (int c = 0; c < 64; ++c) a += pooled[(size_t)tg * 256 + g * 64 + c] * pw[(g * 64 + c) * 64 + d];
    Yraw[(size_t)tg * D + dd] = a * ps[dd];
}
__device__ __forceinline__ float dot_row64(const bf16_t* __restrict__ krow, float qreg) {
    float a = 0.f;
#pragma unroll
    for (int c = 0; c < 8; ++c) {
        const bf16x8 kv = *(const bf16x8*)(krow + 8 * c);
#pragma unroll
        for (int j = 0; j < 8; ++j) a += __shfl(qreg, 8 * c + j) * bf2f((unsigned short)kv[j]);
    }
    return a;
}
__global__ __launch_bounds__(256) void chunk_attn_naive(const bf16_t* __restrict__ H, const float* __restrict__ rb, float* __restrict__ Yraw) {
    const int lane = threadIdx.x & 63, wid = threadIdx.x >> 6;
    const int item = blockIdx.x * 4 + wid, tg = item / 6, h = item % 6, b = tg / SEQ, t = tg % SEQ, chunk = t >> 6, qi = t & 63;
    const float qreg = bf2f(H[(size_t)tg * DIN + C_QC + h * 64 + lane]);
    float sc[9]; float mx = -3.0e38f;
#pragma unroll
    for (int i = 0; i < 9; ++i) {
        const int kc = chunk - 8 + i, j = lane + 64 * i;
        const int kcc = kc < 0 ? 0 : kc;
        const float dot = dot_row64(H + (size_t)(b * SEQ + kcc * 64 + lane) * DIN + C_KC + h * 64, qreg);
        int rel = qi + 512 - j; rel = rel < -128 ? -128 : (rel > 128 ? 128 : rel);
        float s = dot * 0.125f + rb[h * 257 + rel + 128];
        if (kc < 0) s = -1e30f;
        sc[i] = s; mx = fmaxf(mx, s);
    }
    mx = wave_max(mx);
    float sum = 0.f;
#pragma unroll
    for (int i = 0; i < 9; ++i) { sc[i] = expf(sc[i] - mx); sum += sc[i]; }
    sum = wave_sum(sum);
    const float inv = 1.f / sum;
    float o = 0.f;
#pragma unroll
    for (int i = 0; i < 9; ++i) {
        const int kc = chunk - 8 + i;
        if (kc < 0) continue;
        const bf16_t* vb = H + (size_t)(b * SEQ + kc * 64) * DIN + C_VC + h * 64 + lane;
        for (int l = 0; l < 64; ++l) o += __shfl(sc[i], l) * bf2f(vb[(size_t)l * DIN]);
    }
    Yraw[(size_t)tg * D + 256 + h * 64 + lane] = o * inv;
}
__global__ __launch_bounds__(256) void sb_attn_naive(const bf16_t* __restrict__ H, float* __restrict__ Yraw) {
    const int lane = threadIdx.x & 63, wid = threadIdx.x >> 6;
    const int item = blockIdx.x * 4 + wid, tg = item / 6, h = item % 6, b = tg / SEQ, t = tg % SEQ;
    const float qreg = bf2f(H[(size_t)tg * DIN + C_QS + h * 64 + lane]);
    float carry = 0.f, o = 0.f;
    for (int base = t - 1; base >= 0; base -= 64) {
        const int s = base - lane; const bool valid = s >= 0; const int sc_ = valid ? s : 0;
        const float z = dot_row64(H + (size_t)(b * SEQ + sc_) * DIN + C_KS + h * 64, qreg) * 0.125f;
        float lk = -(fmaxf(z, 0.f) + log1pf(expf(-fabsf(z))));
        if (!valid) lk = 0.f;
        float incl = lk;
#pragma unroll
        for (int off = 1; off < 64; off <<= 1) { const float tmp = __shfl_up(incl, off); if (lane >= off) incl += tmp; }
        const float suffix = carry + (incl - lk);
        const float w = valid ? expf(z + lk + suffix) : 0.f;
        carry += __shfl(incl, 63);
        const int nk = base + 1 < 64 ? base + 1 : 64;
        const bf16_t* vb = H + (size_t)(b * SEQ) * DIN + C_VS + h * 64 + lane;
        for (int l = 0; l < nk; ++l) o += __shfl(w, l) * bf2f(vb[(size_t)(base - l) * DIN]);
    }
    Yraw[(size_t)tg * D + 640 + h * 64 + lane] = o;
}
__global__ __launch_bounds__(256) void rms_cat(const float* __restrict__ Yraw, const float* __restrict__ gmix, bf16_t* __restrict__ Yb) {
    const int lane = threadIdx.x & 63, wid = threadIdx.x >> 6, tg = blockIdx.x * 4 + wid;
    const float* y = Yraw + (size_t)tg * D;
    float v[16]; float s0 = 0.f, s1 = 0.f, s2 = 0.f;
#pragma unroll
    for (int i = 0; i < 16; ++i) { v[i] = y[lane + 64 * i]; const float q = v[i] * v[i]; if (i < 4) s0 += q; else if (i < 10) s1 += q; else s2 += q; }
    s0 = wave_sum(s0); s1 = wave_sum(s1); s2 = wave_sum(s2);
    const float r0 = 1.f / sqrtf(s0 / 256.f + RMS_EPS), r1 = 1.f / sqrtf(s1 / 384.f + RMS_EPS), r2 = 1.f / sqrtf(s2 / 384.f + RMS_EPS);
#pragma unroll
    for (int i = 0; i < 16; ++i) { const float r = i < 4 ? r0 : (i < 10 ? r1 : r2); Yb[(size_t)tg * D + lane + 64 * i] = f2bf(v[i] * r * gmix[lane + 64 * i]); }
}
__global__ __launch_bounds__(256) void ln_res(const float* xi, const float* __restrict__ m, const float* __restrict__ g, const float* __restrict__ be, float* xo, bf16_t* __restrict__ xb) {
    const int lane = threadIdx.x & 63, wid = threadIdx.x >> 6, tg = blockIdx.x * 4 + wid;
    float v[16]; float s = 0.f;
#pragma unroll
    for (int i = 0; i < 16; ++i) { const size_t o = (size_t)tg * D + lane + 64 * i; v[i] = ALPHA * xi[o] + m[o]; s += v[i]; }
    const float mean = wave_sum(s) * (1.f / D); float q = 0.f;
#pragma unroll
    for (int i = 0; i < 16; ++i) { v[i] -= mean; q += v[i] * v[i]; }
    const float rstd = 1.f / sqrtf(wave_sum(q) * (1.f / D) + LN_EPS);
#pragma unroll
    for (int i = 0; i < 16; ++i) { const int c = lane + 64 * i; const float y = v[i] * rstd * g[c] + be[c]; xo[(size_t)tg * D + c] = y; xb[(size_t)tg * D + c] = f2bf(y); }
}
__global__ __launch_bounds__(256) void router_naive(const float* __restrict__ x, const float* __restrict__ rw, float* __restrict__ gates) {
    const int lane = threadIdx.x & 63, wid = threadIdx.x >> 6, tg = blockIdx.x * 4 + wid;
    float lg[8];
#pragma unroll
    for (int e = 0; e < 8; ++e) lg[e] = 0.f;
    for (int i = 0; i < 16; ++i) { const int c = lane + 64 * i; const float xv = x[(size_t)tg * D + c];
#pragma unroll
        for (int e = 0; e < 8; ++e) lg[e] += xv * rw[c * 8 + e]; }
#pragma unroll
    for (int e = 0; e < 8; ++e) lg[e] = wave_sum(lg[e]);
    int i1 = 0; float v1 = lg[0];
#pragma unroll
    for (int e = 1; e < 8; ++e) if (lg[e] > v1) { v1 = lg[e]; i1 = e; }
    int i2 = -1; float v2 = -3.0e38f;
#pragma unroll
    for (int e = 0; e < 8; ++e) if (e != i1 && lg[e] > v2) { v2 = lg[e]; i2 = e; }
    const float e2 = expf(v2 - v1), w1 = 1.f / (1.f + e2), w2 = e2 / (1.f + e2);
    if (lane < 8) gates[tg * 8 + lane] = lane == i1 ? w1 : (lane == i2 ? w2 : 0.f);
}

extern "C" void kernel_launch(void* const* d_in, const int* in_sizes, int n_in, void* d_out, int out_size, void* d_ws, size_t ws_size, hipStream_t stream) {
    const float* x = (const float*)d_in[0];
    const float* w_in = (const float*)d_in[1];
    const float* pool_w = (const float*)d_in[2];
    const float* pool_scale = (const float*)d_in[3];
    const float* rel_bias = (const float*)d_in[4];
    const float* g_mix = (const float*)d_in[5];
    const float* w_out = (const float*)d_in[6];
    const float* ln1_g = (const float*)d_in[7];
    const float* ln1_b = (const float*)d_in[8];
    const float* ln2_g = (const float*)d_in[9];
    const float* ln2_b = (const float*)d_in[10];
    const float* ffn_wg = (const float*)d_in[11];
    const float* ffn_wu = (const float*)d_in[12];
    const float* ffn_wd = (const float*)d_in[13];
    const float* moe_router = (const float*)d_in[14];
    const float* moe_wg = (const float*)d_in[15];
    const float* moe_wu = (const float*)d_in[16];
    const float* moe_wd = (const float*)d_in[17];
    float* X = (float*)d_out;
    unsigned char* ws = (unsigned char*)d_ws;
    const size_t MiB = 1u << 20;
    bf16_t* Xb = (bf16_t*)(ws + 0 * MiB);
    bf16_t* H = (bf16_t*)(ws + 32 * MiB);
    float* Yraw = (float*)(ws + 112 * MiB);
    bf16_t* Yb = (bf16_t*)(ws + 176 * MiB);
    float* Mf = (float*)(ws + 208 * MiB);
    bf16_t* Hff = (bf16_t*)(ws + 272 * MiB);
    float* gates = (float*)(ws + 360 * MiB);
    float* pooled = (float*)(ws + 361 * MiB);

    cvt_x<<<M * D / 256, 256, 0, stream>>>(x, Xb, M * D);
    for (int L = 0; L < 2; ++L) {
        gemm_simple<false, EpiStoreBf16><<<dim3(DIN / 128, M / 128), 256, 0, stream>>>(Xb, D, w_in + (size_t)L * D * DIN, nullptr, DIN, D, EpiStoreBf16{H, DIN, 0});
        pool_a<<<M * 256 / 256, 256, 0, stream>>>(H, pooled);
        pool_b<<<M * 256 / 256, 256, 0, stream>>>(pooled, pool_w + L * 4 * 64 * 64, pool_scale + L * 256, Yraw);
        chunk_attn_naive<<<M * 6 / 4, 256, 0, stream>>>(H, rel_bias + L * 6 * 257, Yraw);
        sb_attn_naive<<<M * 6 / 4, 256, 0, stream>>>(H, Yraw);
        rms_cat<<<M / 4, 256, 0, stream>>>(Yraw, g_mix + L * D, Yb);
        gemm_simple<false, EpiStoreF32><<<dim3(D / 128, M / 128), 256, 0, stream>>>(Yb, D, w_out + (size_t)L * D * D, nullptr, D, D, EpiStoreF32{Mf, D, 0});
        ln_res<<<M / 4, 256, 0, stream>>>(L == 0 ? x : X, Mf, ln1_g + L * D, ln1_b + L * D, X, Xb);
        if (L == 0) {
            gemm_simple<true, EpiSwiglu><<<dim3(DFF / 128, M / 128), 256, 0, stream>>>(Xb, D, ffn_wg, ffn_wu, DFF, D, EpiSwiglu{Hff, DFF, 0});
            gemm_simple<false, EpiStoreF32><<<dim3(D / 128, M / 128), 256, 0, stream>>>(Hff, DFF, ffn_wd, nullptr, D, DFF, EpiStoreF32{Mf, D, 0});
        } else {
            router_naive<<<M / 4, 256, 0, stream>>>(X, moe_router, gates);
            for (int e = 0; e < NEXP; ++e) {
                gemm_simple<true, EpiSwiglu><<<dim3(DFF / 128, M / 128), 256, 0, stream>>>(Xb, D, moe_wg + (size_t)e * D * DFF, moe_wu + (size_t)e * D * DFF, DFF, D, EpiSwiglu{Hff, DFF, 0});
                gemm_simple<false, EpiMoeAcc><<<dim3(D / 128, M / 128), 256, 0, stream>>>(Hff, DFF, moe_wd + (size_t)e * DFF * D, nullptr, D, DFF, EpiMoeAcc{Mf, gates, e, 0});
            }
        }
        ln_res<<<M / 4, 256, 0, stream>>>(X, Mf, ln2_g + L * D, ln2_b + L * D, X, Xb);
    }
}
```

```cpp
#include <hip/hip_runtime.h>
#include <hip/hip_bf16.h>
#include <cstdio>
#include <cstdint>
#include <math.h>
#define ONE_LAUNCH 1
#define DEV_MASK 0x3f
namespace pg8 {
#define PG8_LAS __attribute__((address_space(3)))
typedef unsigned short bf16_t;
typedef short bf16x8 __attribute__((ext_vector_type(8)));
typedef float f32x4 __attribute__((ext_vector_type(4)));
typedef unsigned u32x4 __attribute__((ext_vector_type(4)));
constexpr int BM = 256, BK = 64, HALF = 128, HTB = HALF * BK * 2  , STAGE_BYTES = 8 * HTB, NXCD = 8, WGM = 8;

__host__ __device__ __forceinline__ int lds_byte(int r, int c) { const int st = (r >> 4) * 2 + (c >> 5), rr = r & 15, cc = c & 31, ob = rr * 64 + cc * 2; return st * 1024 + (ob ^ (((ob >> 9) & 1) << 5)); }
__host__ __device__ __forceinline__ void stage_rc(int b, int& R, int& C) { const int st = b / 1024, sb = b % 1024, swz = sb ^ (((sb >> 9) & 1) << 5); R = (st >> 1) * 16 + swz / 64; C = (st & 1) * 32 + (swz % 64) / 2; }
__host__ __device__ __forceinline__ int perm32(int rho) { const int n = rho >> 4, i = rho & 15; return 8 * (i >> 2) + 4 * n + (i & 3); }

struct Unit { int pm, pn; };
struct Gemm { const bf16_t* A; const bf16_t* Bt; int M, N, K; };

struct StaticOrder {
    int nM, nN, nwg, G, c;
    __host__ __device__ void init(int M, int N, int G_, int c_) { nM = M / BM; nN = N / BM; nwg = nM * nN; G = G_; c = c_; }
    __host__ __device__ bool next(int i, Unit& u) const {
        const long L = (long)i * G + c; if (L >= nwg) return false;
        int wgid = (int)L; { const int q = nwg / NXCD, r = nwg % NXCD, xcd = wgid % NXCD, off = wgid / NXCD; wgid = (xcd < r ? xcd * (q + 1) : r * (q + 1) + (xcd - r) * q) + off; }
        const int nig = WGM * nN, gid = wgid / nig, fm = gid * WGM, gsz = (nM - fm) < WGM ? (nM - fm) : WGM;
        u.pm = fm + ((wgid % nig) % gsz); u.pn = (wgid % nig) / gsz; return true;
    }
    __device__ __forceinline__ void a_ready(const Unit&) const {}
    __device__ __forceinline__ void done(const Unit&) const {}
};

__device__ __forceinline__ unsigned cvt_pk_bf16(float lo, float hi) { unsigned r; asm volatile("v_cvt_pk_bf16_f32 %0, %1, %2" : "=v"(r) : "v"(lo), "v"(hi)); return r; }
typedef float f32x2 __attribute__((ext_vector_type(2)));
__device__ __forceinline__ f32x2 gelu_pk(f32x2 v) {
    const f32x2 av = __builtin_elementwise_abs(v), d = av * 0.2316418882f + 1.0f;
    f32x2 t; t.x = __builtin_amdgcn_rcpf(d.x); t.y = __builtin_amdgcn_rcpf(d.y);
    f32x2 q = t * 0.5307027145f + (-0.7265760135f); q = q * t + 0.7107068705f; q = q * t + (-0.142248368f); q = q * t + 0.127414796f; q = q * t;
    const f32x2 s = (v * v) * (-0.72134752044f);
    f32x2 e; e.x = __builtin_amdgcn_exp2f(s.x); e.y = __builtin_amdgcn_exp2f(s.y);
    const f32x2 m = v * (q * e), r = v - m;
    f32x2 o; o.x = v.x < 0.f ? m.x : r.x; o.y = v.y < 0.f ? m.y : r.y; return o;
}

template <int ACT  > struct EpiBf16 {
    static constexpr bool PERM = true, AFTER_DRAIN = false; static_assert(ACT == 0 || ACT == 1, "EpiBf16: ACT is 0 (none) or 1 (gelu_pk)");
    bf16_t* O; int ldc; const float* bias; int split_cols; size_t split_stride; float scale0;
    __device__ __forceinline__ void operator()(const f32x4 (&acc)[2][2][4][2], const Unit& u, int wr, int wc, int fr, int fq) const {
        const int row0 = u.pm * BM + wr * 64 + fr; int colt = u.pn * BM; bf16_t* base = O;
        float sc = 1.f; if (split_cols) { const int t = colt / split_cols; base += (size_t)t * split_stride; colt -= t * split_cols; if (t == 0) sc = scale0; }
        const int col0 = colt + wc * 32 + 8 * fq, bcol0 = u.pn * BM + wc * 32 + 8 * fq;
        f32x4 bv[2][2];
#pragma unroll
        for (int bj = 0; bj < 2; ++bj)
#pragma unroll
            for (int n = 0; n < 2; ++n) bv[bj][n] = bias ? *(const f32x4*)(bias + bcol0 + bj * HALF + 4 * n) : (f32x4){0.f, 0.f, 0.f, 0.f};
#pragma unroll
        for (int ai = 0; ai < 2; ++ai)
#pragma unroll
            for (int m = 0; m < 4; ++m) { bf16_t* rowp = base + (size_t)(row0 + ai * HALF + m * 16) * ldc + col0;
#pragma unroll
                for (int bj = 0; bj < 2; ++bj) { f32x4 v0 = acc[ai][bj][m][0] + bv[bj][0], v1 = acc[ai][bj][m][1] + bv[bj][1];
                    if (ACT == 1) { f32x2 a = gelu_pk((f32x2){v0[0], v0[1]}), b = gelu_pk((f32x2){v0[2], v0[3]}), c = gelu_pk((f32x2){v1[0], v1[1]}), d = gelu_pk((f32x2){v1[2], v1[3]});
                        v0 = (f32x4){a.x, a.y, b.x, b.y}; v1 = (f32x4){c.x, c.y, d.x, d.y}; }
                    v0 = v0 * sc; v1 = v1 * sc; u32x4 w; w.x = cvt_pk_bf16(v0[0], v0[1]); w.y = cvt_pk_bf16(v0[2], v0[3]); w.z = cvt_pk_bf16(v1[0], v1[1]); w.w = cvt_pk_bf16(v1[2], v1[3]);
                    *(u32x4*)(rowp + bj * HALF) = w; } }
    }
};

struct PanelStats {
    unsigned* xbuf;
    unsigned* cnt;
    unsigned* tmo;
    int ntn; float eps;
    unsigned code;
    __device__ __forceinline__ bool run(const f32x4 (&v)[2][2][4][2], const Unit& u, int wr, int wc, int fr, int fq, PG8_LAS unsigned char* lds, int wid, int lane) const {
        typedef float f32x2v __attribute__((ext_vector_type(2)));
        PG8_LAS f32x2v* P = (PG8_LAS f32x2v*)lds;
        PG8_LAS f32x2v* S = (PG8_LAS f32x2v*)(lds + 8192);
        PG8_LAS unsigned* flag = (PG8_LAS unsigned*)(lds + 8192 + 2048);
#pragma unroll
        for (int ai = 0; ai < 2; ++ai)
#pragma unroll
            for (int m = 0; m < 4; ++m) {
                float s = 0.f;
#pragma unroll
                for (int bj = 0; bj < 2; ++bj)
#pragma unroll
                    for (int n = 0; n < 2; ++n) { const f32x4 x = v[ai][bj][m][n]; s += (x[0] + x[1]) + (x[2] + x[3]); }
                s += __shfl_xor(s, 16); s += __shfl_xor(s, 32);
                const float mw = s * (1.0f / 64.0f); float q = 0.f;
#pragma unroll
                for (int bj = 0; bj < 2; ++bj)
#pragma unroll
                    for (int n = 0; n < 2; ++n) { const f32x4 d = v[ai][bj][m][n] - mw; q += (d[0] * d[0] + d[1] * d[1]) + (d[2] * d[2] + d[3] * d[3]); }
                q += __shfl_xor(q, 16); q += __shfl_xor(q, 32);
                if (fq == 0) P[(ai * HALF + wr * 64 + m * 16 + fr) * 4 + wc] = (f32x2v){mw, q};
            }
        asm volatile("s_waitcnt lgkmcnt(0)" ::: "memory"); __builtin_amdgcn_s_barrier(); asm volatile("" ::: "memory");
#if defined(BROKEN_EXCHANGE_NO_WAIT)
#warning BROKEN CONTROL BUILD: the row-statistics exchange does not wait; results are wrong by design
        if (blockIdx.x >= 64) { const long long t0_ = clock64(); while (clock64() - t0_ < 60000) __builtin_amdgcn_s_sleep(8); }
#endif
        const int row = wid * 32 + (lane & 31);
        if (lane < 32) {
            const f32x2v a = P[row * 4 + 0], b = P[row * 4 + 1], c = P[row * 4 + 2], d = P[row * 4 + 3];
            const float mt = (a.x + b.x + c.x + d.x) * 0.25f;
            const float da = a.x - mt, db = b.x - mt, dc = c.x - mt, dd = d.x - mt;
            const float m2 = (a.y + b.y) + (c.y + d.y) + 64.0f * ((da * da + db * db) + (dc * dc + dd * dd));
            unsigned long long* slot = (unsigned long long*)xbuf + ((size_t)(u.pm * BM + row) * 4 + u.pn);
            __hip_atomic_store(slot, ((unsigned long long)__float_as_uint(m2) << 32) | __float_as_uint(mt), __ATOMIC_RELAXED, __HIP_MEMORY_SCOPE_AGENT);
        }
        asm volatile("s_waitcnt vmcnt(0)" ::: "memory");
        if (lane == 0) __hip_atomic_fetch_add(cnt + 64 * u.pm, 1u, __ATOMIC_RELAXED, __HIP_MEMORY_SCOPE_AGENT);
        if (wid == 0) {
            bool dead = false; const unsigned long long t0 = __builtin_amdgcn_s_memrealtime(); const unsigned want = 8u * (unsigned)ntn;
            for (;;) {
#if defined(BROKEN_EXCHANGE_NO_WAIT)
                break;
#endif
                if ((unsigned)__builtin_amdgcn_readfirstlane(__hip_atomic_load(cnt + 64 * u.pm, __ATOMIC_RELAXED, __HIP_MEMORY_SCOPE_AGENT)) >= want) break;
                if (__builtin_amdgcn_s_memrealtime() - t0 > 2000000ull) {
                    if (lane == 0) { unsigned expect = 0u; __hip_atomic_compare_exchange_strong(tmo + 1, &expect, code | (unsigned)(u.pm & 0xff), __ATOMIC_RELAXED, __ATOMIC_RELAXED, __HIP_MEMORY_SCOPE_AGENT);
                                     __hip_atomic_store(tmo, 1u, __ATOMIC_RELAXED, __HIP_MEMORY_SCOPE_AGENT); }
                    dead = true; break; }
                __builtin_amdgcn_s_sleep(2);
            }
            __builtin_amdgcn_fence(__ATOMIC_ACQUIRE, "agent");
            if (lane == 0) flag[0] = dead ? 1u : 0u;
        }
        asm volatile("s_waitcnt vmcnt(0) lgkmcnt(0)" ::: "memory"); __builtin_amdgcn_s_barrier(); asm volatile("" ::: "memory");
        const bool bad = flag[0] != 0u;
        if (lane < 32) {
            const unsigned long long* slot = (const unsigned long long*)xbuf + (size_t)(u.pm * BM + row) * 4; float mt[4], m2[4]; float ms = 0.f;
#pragma unroll
            for (int t = 0; t < 4; ++t) { if (t < ntn) { const unsigned long long w = __hip_atomic_load(slot + t, __ATOMIC_RELAXED, __HIP_MEMORY_SCOPE_AGENT); mt[t] = __uint_as_float((unsigned)w); m2[t] = __uint_as_float((unsigned)(w >> 32)); } else { mt[t] = 0.f; m2[t] = 0.f; } ms += mt[t]; }
            const float mean = ms / (float)ntn; float q = 0.f;
#pragma unroll
            for (int t = 0; t < 4; ++t) if (t < ntn) { const float dm = mt[t] - mean; q += m2[t] + 256.0f * dm * dm; }
            S[row] = (f32x2v){mean, 1.0f / sqrtf(q / (256.0f * (float)ntn) + eps)};
        }
        asm volatile("s_waitcnt lgkmcnt(0)" ::: "memory"); __builtin_amdgcn_s_barrier(); asm volatile("" ::: "memory");
        return bad;
    }
};
struct EpiLnRes {
    static constexpr bool PERM = false, AFTER_DRAIN = true;
    const float* base; float* out; int ldc; const float* bias; PanelStats st; unsigned poison;
    __device__ __forceinline__ void fused(f32x4 (&acc)[2][2][4][2], const Unit& u, int wr, int wc, int fr, int fq, PG8_LAS unsigned char* lds, int wid, int lane) const {
        typedef float f32x2v __attribute__((ext_vector_type(2)));
        const PG8_LAS f32x2v* S = (const PG8_LAS f32x2v*)(lds + 8192);
        const int col0 = u.pn * BM + wc * 32 + 4 * fq;
#pragma unroll
        for (int bj = 0; bj < 2; ++bj)
#pragma unroll
            for (int n = 0; n < 2; ++n) { const f32x4 bv = bias ? *(const f32x4*)(bias + col0 + bj * HALF + n * 16) : (f32x4){0.f, 0.f, 0.f, 0.f};
#pragma unroll
                for (int ai = 0; ai < 2; ++ai)
#pragma unroll
                    for (int m = 0; m < 4; ++m) acc[ai][bj][m][n] += bv; }
        f32x4 pre[4][2][2];
#pragma unroll
        for (int m = 0; m < 4; ++m) { const size_t off = (size_t)(u.pm * BM + wr * 64 + m * 16 + fr) * ldc + col0;
#pragma unroll
            for (int bj = 0; bj < 2; ++bj)
#pragma unroll
                for (int n = 0; n < 2; ++n) pre[m][bj][n] = *(const f32x4*)(base + off + bj * HALF + n * 16); }
        const bool bad = st.run(acc, u, wr, wc, fr, fq, lds, wid, lane) || poison != 0u;
        const float qnan = __builtin_nanf("");
#pragma unroll
        for (int ai = 0; ai < 2; ++ai)
#pragma unroll
            for (int m = 0; m < 4; ++m) { const int r = ai * HALF + wr * 64 + m * 16 + fr; const f32x2v sr = S[r]; const size_t off = (size_t)(u.pm * BM + r) * ldc + col0;
#pragma unroll
                for (int bj = 0; bj < 2; ++bj)
#pragma unroll
                    for (int n = 0; n < 2; ++n) { const f32x4 bs = ai == 0 ? pre[m][bj][n] : *(const f32x4*)(base + off + bj * HALF + n * 16); f32x4 o = bs + (acc[ai][bj][m][n] - sr.x) * sr.y;
                        if (bad) o = (f32x4){qnan, qnan, qnan, qnan}; *(f32x4*)(out + off + bj * HALF + n * 16) = o; }
                if (m & 1) asm volatile("" ::: "memory"); }
    }
};
struct EpiLnResLn {
    static constexpr bool PERM = false, AFTER_DRAIN = true;
    const float* base; float* out; bf16_t* xn; int ldc; const float* bias; PanelStats st1, st2; unsigned poison;
    __device__ __forceinline__ void fused(f32x4 (&acc)[2][2][4][2], const Unit& u, int wr, int wc, int fr, int fq, PG8_LAS unsigned char* lds, int wid, int lane) const {
        typedef float f32x2v __attribute__((ext_vector_type(2))); typedef unsigned u32x2v __attribute__((ext_vector_type(2)));
        const PG8_LAS f32x2v* S = (const PG8_LAS f32x2v*)(lds + 8192);
        const int col0 = u.pn * BM + wc * 32 + 4 * fq;
#pragma unroll
        for (int bj = 0; bj < 2; ++bj)
#pragma unroll
            for (int n = 0; n < 2; ++n) { const f32x4 bv = bias ? *(const f32x4*)(bias + col0 + bj * HALF + n * 16) : (f32x4){0.f, 0.f, 0.f, 0.f};
#pragma unroll
                for (int ai = 0; ai < 2; ++ai)
#pragma unroll
                    for (int m = 0; m < 4; ++m) acc[ai][bj][m][n] += bv; }
        bool bad = st1.run(acc, u, wr, wc, fr, fq, lds, wid, lane) || poison != 0u;
        const float qnan = __builtin_nanf("");
#pragma unroll
        for (int ai = 0; ai < 2; ++ai)
#pragma unroll
            for (int m = 0; m < 4; ++m) { const int r = ai * HALF + wr * 64 + m * 16 + fr; const f32x2v sr = S[r]; const size_t off = (size_t)(u.pm * BM + r) * ldc + col0;
#pragma unroll
                for (int bj = 0; bj < 2; ++bj)
#pragma unroll
                    for (int n = 0; n < 2; ++n) { const f32x4 bs = *(const f32x4*)(base + off + bj * HALF + n * 16); acc[ai][bj][m][n] = bs + (acc[ai][bj][m][n] - sr.x) * sr.y; }
                asm volatile("" : "+v"(acc[ai][0][m][0]), "+v"(acc[ai][0][m][1]), "+v"(acc[ai][1][m][0]), "+v"(acc[ai][1][m][1]));
                if (m & 1) asm volatile("" ::: "memory"); }
        const bool bad1 = bad;
        bad = st2.run(acc, u, wr, wc, fr, fq, lds, wid, lane) || bad;
#pragma unroll
        for (int ai = 0; ai < 2; ++ai)
#pragma unroll
            for (int m = 0; m < 4; ++m) { const int r = ai * HALF + wr * 64 + m * 16 + fr; const f32x2v sr = S[r]; const size_t off = (size_t)(u.pm * BM + r) * ldc + col0;
#pragma unroll
                for (int bj = 0; bj < 2; ++bj)
#pragma unroll
                    for (int n = 0; n < 2; ++n) { const f32x4 x1 = acc[ai][bj][m][n]; *(f32x4*)(out + off + bj * HALF + n * 16) = bad1 ? (f32x4){qnan, qnan, qnan, qnan} : x1;
                        const f32x4 o = (x1 - sr.x) * sr.y; u32x2v w; w.x = cvt_pk_bf16(o[0], o[1]); w.y = cvt_pk_bf16(o[2], o[3]);
                        if (bad) { w.x = 0x7fc07fc0u; w.y = 0x7fc07fc0u; } *(u32x2v*)(xn + off + bj * HALF + n * 16) = w; }
                asm volatile("" ::: "memory"); }
    }
};

template <class Epi, class Sched, bool ALIGN_EPI = false, bool SP2 = false>
__device__ __forceinline__ void gemm_phase(PG8_LAS unsigned char* lds, const Gemm g, const Sched& S, const Epi& E) {
    const int tid = threadIdx.x, wid = __builtin_amdgcn_readfirstlane(tid >> 6), lane = tid & 63, wr = wid >> 2, wc = wid & 3, fr = lane & 15, fq = lane >> 4;
    const int K = g.K, nt = K / BK;
    unsigned voffA[2], voffB[2];
#pragma unroll
    for (int i = 0; i < 2; ++i) { int R, C; stage_rc(tid * 16 + i * 8192, R, C); const int Rb = Epi::PERM ? ((R & ~31) + perm32(R & 31)) : R;
        voffA[i] = (unsigned)(R * K + C) * 2u; voffB[i] = (unsigned)(Rb * K + C) * 2u; }
    const size_t kstep = (size_t)(BK * 2);
    const size_t hstep = (size_t)HALF * K * 2;
    const size_t tstep = 2 * hstep;
    const unsigned ldsw = (unsigned)wid * 1024u;
    const int aoff = lds_byte(wr * 64 + fr, fq * 8), boff = lds_byte(wc * 32 + fr, fq * 8);
#define PG8_SA(b, h) (((b) * 2 + (h)) * HTB)
#define PG8_SB(b, h) ((4 + (b) * 2 + (h)) * HTB)
#define PG8_STAGE(bufoff, gbase, voff) do { _Pragma("unroll") for (int _i = 0; _i < 2; ++_i) \
        __builtin_amdgcn_global_load_lds((const unsigned*)((const char*)(gbase) + (voff)[_i]), (PG8_LAS unsigned*)(lds + (bufoff) + ldsw + _i * 8192), 16, 0, 0); } while (0)
#define PG8_LDA(dst, b, h) do { _Pragma("unroll") for (int m = 0; m < 4; ++m) _Pragma("unroll") for (int k = 0; k < 2; ++k) dst[m][k] = *(const PG8_LAS bf16x8*)(lds + PG8_SA(b, h) + aoff + m * 2048 + k * 1024); } while (0)
#define PG8_LDB(dst, b, h) do { _Pragma("unroll") for (int n = 0; n < 2; ++n) _Pragma("unroll") for (int k = 0; k < 2; ++k) dst[n][k] = *(const PG8_LAS bf16x8*)(lds + PG8_SB(b, h) + boff + n * 2048 + k * 1024); } while (0)
#define PG8_MMA(ai, bj, At, Bt) do { __builtin_amdgcn_s_setprio(1); _Pragma("unroll") for (int m = 0; m < 4; ++m) _Pragma("unroll") for (int n = 0; n < 2; ++n) _Pragma("unroll") for (int k = 0; k < 2; ++k) \
        acc[ai][bj][m][n] = __builtin_amdgcn_mfma_f32_16x16x32_bf16(Bt[n][k], At[m][k], acc[ai][bj][m][n], 0, 0, 0); __builtin_amdgcn_s_setprio(0); } while (0)
#define PG8_WAIT_V(n) asm volatile("s_waitcnt vmcnt(" #n ")" ::: "memory")
#define PG8_WAIT_L(n) asm volatile("s_waitcnt lgkmcnt(" #n ")" ::: "memory")
#define PG8_BAR __builtin_amdgcn_s_barrier()
#define PG8_SCHED __builtin_amdgcn_sched_barrier(0)
    Unit cur, nxt; int ui = 0;
    if (!S.next(0, cur)) return;
    f32x4 acc[2][2][4][2];
#pragma unroll
    for (int a = 0; a < 2; ++a)
#pragma unroll
        for (int b = 0; b < 2; ++b)
#pragma unroll
            for (int m = 0; m < 4; ++m)
#pragma unroll
                for (int n = 0; n < 2; ++n) acc[a][b][m][n] = (f32x4){0.f, 0.f, 0.f, 0.f};
    bf16x8 At[4][2], B0[2][2], B1[2][2];
    const char* cA = (const char*)g.A + (size_t)cur.pm * tstep; const char* cB = (const char*)g.Bt + (size_t)cur.pn * tstep;
    S.a_ready(cur);
    if constexpr (SP2) {
        PG8_STAGE(PG8_SB(0, 0), cB, voffB); PG8_STAGE(PG8_SB(0, 1), cB + hstep, voffB); PG8_STAGE(PG8_SA(0, 0), cA, voffA); PG8_STAGE(PG8_SA(0, 1), cA + hstep, voffA);
        if (wr == 1) PG8_BAR;
        PG8_WAIT_V(2); PG8_BAR;
        PG8_STAGE(PG8_SB(1, 0), cB + kstep, voffB); PG8_STAGE(PG8_SA(1, 0), cA + kstep, voffA); PG8_STAGE(PG8_SB(1, 1), cB + hstep + kstep, voffB);
        PG8_WAIT_V(6); PG8_BAR;
    } else {
        PG8_STAGE(PG8_SB(0, 0), cB, voffB); PG8_STAGE(PG8_SA(0, 0), cA, voffA); PG8_STAGE(PG8_SB(0, 1), cB + hstep, voffB); PG8_STAGE(PG8_SA(0, 1), cA + hstep, voffA);
        if (wr == 1) PG8_BAR;
        PG8_WAIT_V(4); PG8_BAR;
        PG8_STAGE(PG8_SB(1, 0), cB + kstep, voffB); PG8_STAGE(PG8_SA(1, 0), cA + kstep, voffA); PG8_STAGE(PG8_SB(1, 1), cB + hstep + kstep, voffB);
        PG8_WAIT_V(6); PG8_BAR;
    }
    for (;;) {
        const bool has_next = S.next(ui + 1, nxt);
        const char* nA = has_next ? (const char*)g.A + (size_t)nxt.pm * tstep : cA; const char* nB = has_next ? (const char*)g.Bt + (size_t)nxt.pn * tstep : cB;
        for (int t = 0; t < nt; t += 2) {
            const bool last = (t == nt - 2);
            const char* a1 = cA + (size_t)(t + 1) * kstep;
            const char* a2 = last ? nA : cA + (size_t)(t + 2) * kstep; const char* b2 = last ? nB : cB + (size_t)(t + 2) * kstep;
            const char* a3 = a2 + kstep; const char* b3 = b2 + kstep;
            if (last && has_next) S.a_ready(nxt);
            if constexpr (SP2) {
            PG8_LDB(B0, 0, 0); PG8_LDB(B1, 0, 1); PG8_SCHED; PG8_LDA(At, 0, 0); PG8_STAGE(PG8_SA(1, 1), a1 + hstep, voffA);
            PG8_WAIT_V(8); PG8_WAIT_L(0); PG8_BAR; PG8_MMA(0, 0, At, B0); PG8_MMA(0, 1, At, B1); PG8_BAR; PG8_SCHED;
            PG8_LDA(At, 0, 1); PG8_STAGE(PG8_SB(0, 0), b2, voffB); PG8_STAGE(PG8_SB(0, 1), b2 + hstep, voffB); PG8_STAGE(PG8_SA(0, 0), a2, voffA);
            PG8_WAIT_V(8); PG8_WAIT_L(0); PG8_BAR; PG8_MMA(1, 0, At, B0); PG8_MMA(1, 1, At, B1); PG8_BAR; PG8_SCHED;
            PG8_LDB(B0, 1, 0); PG8_LDB(B1, 1, 1); PG8_SCHED; PG8_LDA(At, 1, 0); PG8_STAGE(PG8_SA(0, 1), a2 + hstep, voffA);
            PG8_WAIT_V(8); PG8_WAIT_L(0); PG8_BAR; PG8_MMA(0, 0, At, B0); PG8_MMA(0, 1, At, B1); PG8_BAR; PG8_SCHED;
            PG8_LDA(At, 1, 1); PG8_STAGE(PG8_SB(1, 0), b3, voffB); PG8_STAGE(PG8_SB(1, 1), b3 + hstep, voffB); PG8_STAGE(PG8_SA(1, 0), a3, voffA);
            PG8_WAIT_V(8); PG8_WAIT_L(0); PG8_BAR; PG8_MMA(1, 0, At, B0); PG8_MMA(1, 1, At, B1); PG8_BAR; PG8_SCHED;
            } else {
            PG8_LDB(B0, 0, 0); PG8_SCHED; PG8_LDA(At, 0, 0); PG8_STAGE(PG8_SA(1, 1), a1 + hstep, voffA);
            PG8_WAIT_L(8); PG8_BAR; PG8_WAIT_L(0); PG8_MMA(0, 0, At, B0); PG8_BAR; PG8_SCHED;
            PG8_LDB(B1, 0, 1); PG8_STAGE(PG8_SB(0, 0), b2, voffB);
            PG8_BAR; PG8_WAIT_L(0); PG8_MMA(0, 1, At, B1); PG8_BAR;
            PG8_LDA(At, 0, 1); PG8_STAGE(PG8_SA(0, 0), a2, voffA);
            PG8_BAR; PG8_WAIT_L(0); PG8_MMA(1, 0, At, B0); PG8_BAR; PG8_SCHED;
            PG8_STAGE(PG8_SB(0, 1), b2 + hstep, voffB);
            PG8_WAIT_V(6); PG8_BAR; PG8_MMA(1, 1, At, B1); PG8_BAR;
            PG8_LDB(B0, 1, 0); PG8_SCHED; PG8_LDA(At, 1, 0); PG8_STAGE(PG8_SA(0, 1), a2 + hstep, voffA);
            PG8_WAIT_L(8); PG8_BAR; PG8_WAIT_L(0); PG8_MMA(0, 0, At, B0); PG8_BAR; PG8_SCHED;
            PG8_LDB(B1, 1, 1); PG8_STAGE(PG8_SB(1, 0), b3, voffB);
            PG8_BAR; PG8_WAIT_L(0); PG8_MMA(0, 1, At, B1); PG8_BAR;
            PG8_LDA(At, 1, 1); PG8_STAGE(PG8_SA(1, 0), a3, voffA);
            PG8_BAR; PG8_WAIT_L(0); PG8_MMA(1, 0, At, B0); PG8_BAR; PG8_SCHED;
            PG8_STAGE(PG8_SB(1, 1), b3 + hstep, voffB);
            PG8_WAIT_V(6); PG8_BAR; PG8_MMA(1, 1, At, B1); PG8_BAR;
            }
        }
        if constexpr (ALIGN_EPI) { if (wr == 0) PG8_BAR; }
        if constexpr (!Epi::AFTER_DRAIN) { E(acc, cur, wr, wc, fr, fq); S.done(cur); }
        if (!has_next) break;
#pragma unroll
        for (int a = 0; a < 2; ++a)
#pragma unroll
            for (int b = 0; b < 2; ++b)
#pragma unroll
                for (int m = 0; m < 4; ++m)
#pragma unroll
                    for (int n = 0; n < 2; ++n) acc[a][b][m][n] = (f32x4){0.f, 0.f, 0.f, 0.f};
        cur = nxt; cA = nA; cB = nB; ++ui;
        if constexpr (ALIGN_EPI) { if (wr == 1) PG8_BAR; }
    }
    PG8_WAIT_V(0);
    if constexpr (!ALIGN_EPI) { if (wr == 0) PG8_BAR; }
    PG8_BAR;
    if constexpr (Epi::AFTER_DRAIN) { E.fused(acc, cur, wr, wc, fr, fq, lds, wid, lane); S.done(cur); }
#undef PG8_SA
#undef PG8_SB
#undef PG8_STAGE
#undef PG8_LDA
#undef PG8_LDB
#undef PG8_MMA
#undef PG8_WAIT_V
#undef PG8_WAIT_L
#undef PG8_BAR
#undef PG8_SCHED
}
}
namespace pg8 {
struct EpiF32 {
    static constexpr bool PERM = false, AFTER_DRAIN = false;
    float* C; int ldc; int pad;
    __device__ __forceinline__ void operator()(const f32x4 (&acc)[2][2][4][2], const Unit& u, int wr, int wc, int fr, int fq) const {
        const int row0 = u.pm * BM + wr * 64 + fr, col0 = u.pn * BM + wc * 32 + 4 * fq;
#pragma unroll
        for (int ai = 0; ai < 2; ++ai)
#pragma unroll
            for (int m = 0; m < 4; ++m) { float* rowp = C + (size_t)(row0 + ai * HALF + m * 16) * ldc + col0;
#pragma unroll
                for (int bj = 0; bj < 2; ++bj)
#pragma unroll
                    for (int n = 0; n < 2; ++n) *(f32x4*)(rowp + bj * HALF + n * 16) = acc[ai][bj][m][n]; }
    }
};
struct EpiStoreBf16P {
    static constexpr bool PERM = true, AFTER_DRAIN = false;
    bf16_t* O; int ldc; int npn;
    __device__ __forceinline__ void operator()(const f32x4 (&acc)[2][2][4][2], const Unit& u, int wr, int wc, int fr, int fq) const {
        const int row0 = u.pm * BM + wr * 64 + fr, col0 = (u.pn % npn) * BM + wc * 32 + 8 * fq;
#pragma unroll
        for (int ai = 0; ai < 2; ++ai)
#pragma unroll
            for (int m = 0; m < 4; ++m) { bf16_t* rowp = O + (size_t)(row0 + ai * HALF + m * 16) * ldc + col0;
#pragma unroll
                for (int bj = 0; bj < 2; ++bj) { const f32x4 v0 = acc[ai][bj][m][0], v1 = acc[ai][bj][m][1];
                    u32x4 w; w.x = cvt_pk_bf16(v0[0], v0[1]); w.y = cvt_pk_bf16(v0[2], v0[3]); w.z = cvt_pk_bf16(v1[0], v1[1]); w.w = cvt_pk_bf16(v1[2], v1[3]);
                    *(u32x4*)(rowp + bj * HALF) = w; } }
    }
};
__device__ __forceinline__ float silu_mul(float g, float u) { return g * u * __builtin_amdgcn_rcpf(1.0f + __builtin_amdgcn_exp2f(-1.4426950408889634f * g)); }
struct EpiSwiGLU {
    static constexpr bool PERM = true, AFTER_DRAIN = false;
    bf16_t* O; int ldc; int npn;
    __device__ __forceinline__ void operator()(const f32x4 (&acc)[2][2][4][2], const Unit& u, int wr, int wc, int fr, int fq) const {
        const int row0 = u.pm * BM + wr * 64 + fr, col0 = (u.pn % npn) * HALF + wc * 32 + 8 * fq;
#pragma unroll
        for (int ai = 0; ai < 2; ++ai)
#pragma unroll
            for (int m = 0; m < 4; ++m) { bf16_t* rowp = O + (size_t)(row0 + ai * HALF + m * 16) * ldc + col0;
                const f32x4 g0 = acc[ai][0][m][0], g1 = acc[ai][0][m][1], u0 = acc[ai][1][m][0], u1 = acc[ai][1][m][1];
                u32x4 w; w.x = cvt_pk_bf16(silu_mul(g0[0], u0[0]), silu_mul(g0[1], u0[1])); w.y = cvt_pk_bf16(silu_mul(g0[2], u0[2]), silu_mul(g0[3], u0[3]));
                w.z = cvt_pk_bf16(silu_mul(g1[0], u1[0]), silu_mul(g1[1], u1[1])); w.w = cvt_pk_bf16(silu_mul(g1[2], u1[2]), silu_mul(g1[3], u1[3]));
                *(u32x4*)rowp = w; }
    }
};
struct GroupedOrder {
    StaticOrder so; int npn; int ts[9];
    __device__ __forceinline__ bool next(int i, Unit& u) const {
        if (!so.next(i, u)) return false;
        int e = 0;
#pragma unroll
        for (int j = 1; j < 8; ++j) e += (u.pm >= ts[j]) ? 1 : 0;
        u.pn += e * npn; return true;
    }
    __device__ __forceinline__ void a_ready(const Unit&) const {}
    __device__ __forceinline__ void done(const Unit&) const {}
};
}
#ifndef PG8_SP2
#define PG8_SP2 true
#endif
#ifndef PG8_ALIGN
#define PG8_ALIGN true
#endif

constexpr int NWAVES = 8;
constexpr int D = 1024, BATCH = 4, SEQ = 4096, M = BATCH * SEQ;
constexpr int DIN = 2560, DFF = 2816, NEXP = 8;
constexpr int C_POOL = 0, C_QC = 256, C_KC = 640, C_VC = 1024, C_QS = 1408, C_KS = 1792, C_VS = 2176;
constexpr float ALPHA = 1.4142135623730951f, LN_EPS = 1e-5f, RMS_EPS = 1e-6f, LOG2E = 1.4426950408889634f;
constexpr int MAXSLOT = 34816, MAXTILES = MAXSLOT / 256;

constexpr size_t MiB = 1u << 20;
constexpr size_t WS_CTL = 0, CTL_ZERO_BYTES = 64 * 1024;
constexpr size_t WS_TOKE = 64 * 1024, WS_TOKW = 192 * 1024, WS_TOKS = 320 * 1024, WS_CNT = 448 * 1024, WS_GATES = 512 * 1024;
constexpr size_t WS_MWGU = 1 * MiB, WS_MWD = 89 * MiB;
constexpr size_t WS_WIN = 133 * MiB, WS_WOUT = 143 * MiB, WS_WGU = 147 * MiB, WS_WD = 158 * MiB;
constexpr size_t WS_HB = 164 * MiB, WS_YB = 252 * MiB, WS_MF = 284 * MiB, WS_XB = 348 * MiB;
constexpr size_t WS_XPERM = 133 * MiB, WS_HPERM = 201 * MiB, WS_YPERM = 1 * MiB, WS_END = 388 * MiB;
constexpr int CW_TMO = 0, CW_CODE = 1, CW_BAR = 4096;

constexpr int RING_OFF = 0, RING_BYTES = 131072;
constexpr int LDSCTL_OFF = RING_BYTES, MISC_OFF = LDSCTL_OFF + 320;
constexpr int LDS_BYTES = 147456;

#define GAS __attribute__((address_space(1)))
#define LAS __attribute__((address_space(3)))
typedef unsigned short bf16;
typedef unsigned v4u __attribute__((ext_vector_type(4)));
typedef unsigned v2u __attribute__((ext_vector_type(2)));
typedef float f32x4 __attribute__((ext_vector_type(4)));
typedef float f32x16 __attribute__((ext_vector_type(16)));
typedef short bf16x8 __attribute__((ext_vector_type(8)));
typedef GAS unsigned gu32;
#define RLX_AGENT __ATOMIC_RELAXED, __HIP_MEMORY_SCOPE_AGENT
#define LDS_WAIT() asm volatile("s_waitcnt lgkmcnt(0)" ::: "memory")
#define VM_WAIT() asm volatile("s_waitcnt vmcnt(0)" ::: "memory")
__device__ __forceinline__ unsigned f2bf(float f) { unsigned u = __builtin_bit_cast(unsigned, f); return (u + 0x7fffu + ((u >> 16) & 1u)) >> 16; }
__device__ __forceinline__ unsigned pk2(float lo, float hi) { return f2bf(lo) | (f2bf(hi) << 16); }
__device__ __forceinline__ float bf2f(unsigned short h) { return __uint_as_float(((unsigned)h) << 16); }
__device__ __forceinline__ float bflo(unsigned w) { return __uint_as_float(w << 16); }
__device__ __forceinline__ float bfhi(unsigned w) { return __uint_as_float(w & 0xffff0000u); }
__device__ __forceinline__ float wave_sum(float v) {
#pragma unroll
    for (int o = 1; o < 64; o <<= 1) v += __shfl_xor(v, o);
    return v;
}
#define XB_TMO      128
#define XB_XCNT(j)  (256  + 64 * (j))
#define XB_XSUB(j)  (1280 + 64 * (j))
#define XB_XGEN(j)  (2304 + 64 * (j))
#define XB_TOP      3328
#define XB_TOPGEN   3392
#define XCD_BAR_WORDS 3456
#define XB_SPIN_CAP (1u << 18)

__device__ __forceinline__ unsigned xb_ld(unsigned* p)              { return __hip_atomic_load(p, __ATOMIC_RELAXED, __HIP_MEMORY_SCOPE_AGENT); }
__device__ __forceinline__ unsigned xb_add(unsigned* p, unsigned v) { return __hip_atomic_fetch_add(p, v, __ATOMIC_RELAXED, __HIP_MEMORY_SCOPE_AGENT); }
__device__ __forceinline__ unsigned xb_xcc_id() { return (unsigned)__builtin_amdgcn_s_getreg((3 << 11) | 20) & 0xFu; }
#define XB_SPIN(cond, bar) do { unsigned _sp = 0; while (cond) { __builtin_amdgcn_s_sleep(1); \
    if ((++_sp & 255u) == 0u) { if (xb_ld(&(bar)[XB_TMO])) break; if (_sp > XB_SPIN_CAP) { atomicAdd(&(bar)[XB_TMO], 1u); break; } } } } while (0)

struct XcdBarrier {
    unsigned* bar; unsigned x;
    volatile LAS unsigned* st;
};

__device__ __forceinline__ XcdBarrier xcd_barrier_post(unsigned* bar, volatile LAS unsigned* st) {
    XcdBarrier b; b.bar = bar; b.x = xb_xcc_id(); b.st = st;
    if (threadIdx.x == 0) (void)xb_add(&bar[XB_XCNT(b.x)], 1u);
    return b;
}
__device__ __forceinline__ void xcd_barrier_complete(unsigned* bar, unsigned x, unsigned& nloc, unsigned& nx) {
    const unsigned G = gridDim.x * gridDim.y * gridDim.z;
    unsigned sum, cnt, mine, sp = 0u;
    for (;;) {
        sum = 0u; cnt = 0u; mine = 0u;
#pragma unroll
        for (unsigned j = 0; j < 16; ++j) { const unsigned c = xb_ld(&bar[XB_XCNT(j)]); sum += c; cnt += (c > 0u) ? 1u : 0u; mine = (j == x) ? c : mine; }
        if (sum == G) break;
        __builtin_amdgcn_s_sleep(1);
        if ((++sp & 255u) == 0u) { if (xb_ld(&bar[XB_TMO])) break; if (sp > XB_SPIN_CAP) { atomicAdd(&bar[XB_TMO], 1u); break; } }
    }
    nloc = mine > 0u ? mine : 1u; nx = cnt > 0u ? cnt : 1u;
}

__device__ __forceinline__ void xcd_barrier(const XcdBarrier& b) {
    asm volatile("s_waitcnt vmcnt(0)" ::: "memory");
    __syncthreads();
    if (threadIdx.x == 0) {
        unsigned* bar = b.bar;
        __builtin_amdgcn_s_waitcnt(0);
        unsigned nloc = b.st[0], nx = b.st[1];
        if (nloc == 0u) { xcd_barrier_complete(bar, b.x, nloc, nx); b.st[0] = nloc; b.st[1] = nx; }
        const unsigned old = xb_add(&bar[XB_XSUB(b.x)], 1u);
        const unsigned gen = old / nloc;
        if (old + 1u == (gen + 1u) * nloc) {
            __builtin_amdgcn_fence(__ATOMIC_RELEASE, "agent");
            asm volatile("s_waitcnt vmcnt(0)" ::: "memory");
            const unsigned og = xb_add(&bar[XB_TOP], 1u);
            const unsigned tg = og / nx;
            if (og + 1u == (tg + 1u) * nx) xb_add(&bar[XB_TOPGEN], 1u);
            else XB_SPIN(xb_ld(&bar[XB_TOPGEN]) == tg, bar);
            __builtin_amdgcn_fence(__ATOMIC_ACQUIRE, "agent");
            xb_add(&bar[XB_XGEN(b.x)], 1u);
            asm volatile("s_waitcnt vmcnt(0)" ::: "memory");
        } else {
            XB_SPIN(xb_ld(&bar[XB_XGEN(b.x)]) == gen, bar);
            __builtin_amdgcn_fence(__ATOMIC_ACQUIRE, "agent");
            asm volatile("s_waitcnt vmcnt(0)" ::: "memory");
        }
    }
    __syncthreads();
}
#ifndef MIXER_INLINE
#define MIXER_INLINE __forceinline__
#endif
constexpr int MX_SSQ = 0, MX_BIAS = 1024, MX_U = 8192, MX_P = 8192 + 40960, MX_V = 8192, MX_VW = 9216, MX_VP = 144;
typedef short v4i16_t __attribute__((ext_vector_type(4)));
#define MFMA32(a, b, c) __builtin_amdgcn_mfma_f32_32x32x16_bf16((a), (b), (c), 0, 0, 0)
__device__ __forceinline__ bf16x8 vtr2(const LAS unsigned char* p0, const LAS unsigned char* p1) {
    const v4i16_t a = __builtin_amdgcn_ds_read_tr16_b64_v4i16((LAS v4i16_t*)p0), b = __builtin_amdgcn_ds_read_tr16_b64_v4i16((LAS v4i16_t*)p1);
    return (bf16x8){a[0], a[1], a[2], a[3], b[0], b[1], b[2], b[3]};
}
__device__ __forceinline__ bf16x8 pack8(const f32x16& p, int base) {
    v4u w; w.x = pk2(p[base], p[base + 1]); w.y = pk2(p[base + 2], p[base + 3]); w.z = pk2(p[base + 4], p[base + 5]); w.w = pk2(p[base + 6], p[base + 7]);
    return __builtin_bit_cast(bf16x8, w);
}
__device__ __forceinline__ void stage_v(const GAS bf16* __restrict__ vsrc  , LAS unsigned char* vt, int lane) {
#pragma unroll
    for (int i = 0; i < 8; ++i) { const int c8 = lane + 64 * i, key = c8 >> 3, part = c8 & 7;
        const v4u v = *(const GAS v4u*)(vsrc + (size_t)key * DIN + part * 8); *(LAS v4u*)(vt + key * MX_VP + part * 16) = v; }
}
__device__ __forceinline__ void pv_block(f32x16& o0, f32x16& o1, const f32x16& p, const LAS unsigned char* vt, int kb, int lane) {
    const int hi = lane >> 5, blk = (lane >> 4) & 1, qq = (lane & 15) >> 2, pp = lane & 3;
#pragma unroll
    for (int sh = 0; sh < 2; ++sh) {
        const bf16x8 pf = pack8(p, 8 * sh);
        const LAS unsigned char* base = vt + (32 * kb + 16 * sh + 4 * hi + qq) * MX_VP + 32 * blk + 8 * pp;
        const bf16x8 v0 = vtr2(base, base + 8 * MX_VP), v1 = vtr2(base + 64, base + 64 + 8 * MX_VP);
        o0 = MFMA32(v0, pf, o0); o1 = MFMA32(v1, pf, o1);
    }
}
__device__ __forceinline__ void store_ot(GAS float* __restrict__ yrow  , const f32x16& o0, const f32x16& o1, float scale, LAS float* ssq_slot, int lane) {
    const int hi = lane >> 5; float q = 0.f;
#pragma unroll
    for (int gq = 0; gq < 4; ++gq) {
        f32x4 a, b;
#pragma unroll
        for (int i = 0; i < 4; ++i) { a[i] = o0[4 * gq + i] * scale; b[i] = o1[4 * gq + i] * scale; q += a[i] * a[i] + b[i] * b[i]; }
        *(GAS f32x4*)(yrow + 8 * gq + 4 * hi) = a; *(GAS f32x4*)(yrow + 32 + 8 * gq + 4 * hi) = b;
    }
    q += __shfl_xor(q, 32);
    if (hi == 0) __hip_atomic_fetch_add(ssq_slot, q, __ATOMIC_RELAXED, __HIP_MEMORY_SCOPE_WORKGROUP);
}

__device__ __forceinline__ void chunk_item(const GAS bf16* __restrict__ H, GAS float* __restrict__ Yraw, LAS unsigned char* lds, int b, int chunk, int h, int qh, int wave, int lane) {
    const int r32 = lane & 31, hi = lane >> 5;
    const size_t row0 = (size_t)b * SEQ + chunk * 64;
    const LAS float* biasl = (const LAS float*)(lds + MX_BIAS) + h * 260;
    LAS unsigned char* vt = lds + MX_V + wave * MX_VW;
    bf16x8 qf[4];
#pragma unroll
    for (int s = 0; s < 4; ++s) qf[s] = *(const GAS bf16x8*)(H + (row0 + 32 * qh + r32) * DIN + C_QC + h * 64 + 16 * s + 8 * hi);
    f32x16 o0 = {}, o1 = {};
    float m = -1e30f, l = 0.f;
    const float c1 = 0.125f * LOG2E;
    for (int kt = chunk >= 8 ? 0 : 8 - chunk; kt <= 8; ++kt) {
        const size_t krow0 = (size_t)b * SEQ + (size_t)(chunk - 8 + kt) * 64;
        stage_v(H + krow0 * DIN + C_VC + h * 64, vt, lane);
        f32x16 s0 = {}, s1 = {};
#pragma unroll
        for (int s = 0; s < 4; ++s) {
            const bf16x8 k0 = *(const GAS bf16x8*)(H + (krow0 + r32) * DIN + C_KC + h * 64 + 16 * s + 8 * hi);
            const bf16x8 k1 = *(const GAS bf16x8*)(H + (krow0 + 32 + r32) * DIN + C_KC + h * 64 + 16 * s + 8 * hi);
            s0 = MFMA32(k0, qf[s], s0); s1 = MFMA32(k1, qf[s], s1);
        }
        if (kt <= 5) {
            const float bc = biasl[256];
#pragma unroll
            for (int r = 0; r < 16; ++r) { s0[r] = s0[r] * c1 + bc; s1[r] = s1[r] * c1 + bc; }
        } else {
            const int base = 64 * (8 - kt) + 32 * qh + r32 - 4 * hi + 128;
#pragma unroll
            for (int r = 0; r < 16; ++r) { const int ro = (r & 3) + 8 * (r >> 2);
                int i0 = base - ro, i1 = base - 32 - ro; i0 = i0 < 0 ? 0 : (i0 > 256 ? 256 : i0); i1 = i1 < 0 ? 0 : (i1 > 256 ? 256 : i1);
                s0[r] = s0[r] * c1 + biasl[i0]; s1[r] = s1[r] * c1 + biasl[i1]; }
        }
        float ml = fmaxf(s0[0], s1[0]);
#pragma unroll
        for (int r = 1; r < 16; ++r) ml = fmaxf(ml, fmaxf(s0[r], s1[r]));
        ml = fmaxf(ml, __shfl_xor(ml, 32));
        const float mn = fmaxf(m, ml), al = __builtin_amdgcn_exp2f(m - mn); m = mn;
        float ps = 0.f;
#pragma unroll
        for (int r = 0; r < 16; ++r) { s0[r] = __builtin_amdgcn_exp2f(s0[r] - mn); s1[r] = __builtin_amdgcn_exp2f(s1[r] - mn); ps += s0[r] + s1[r]; }
        l = l * al + ps;
#pragma unroll
        for (int r = 0; r < 16; ++r) { o0[r] *= al; o1[r] *= al; }
        pv_block(o0, o1, s0, vt, 0, lane);
        pv_block(o0, o1, s1, vt, 1, lane);
    }
    l += __shfl_xor(l, 32);
    store_ot(Yraw + (row0 + 32 * qh + r32) * D + 256 + h * 64, o0, o1, 1.0f / l, (LAS float*)(lds + MX_SSQ) + (32 * qh + r32) * 4 + 1, lane);
}

#define SB_BLOCK(KB) do { \
    f32x16 sa = {}; \
    _Pragma("unroll") for (int s = 0; s < 4; ++s) { \
        const bf16x8 kf = *(const GAS bf16x8*)(H + (krow0 + 32 * (KB) + r32) * DIN + C_KS + h * 64 + 16 * s + 8 * hi); \
        sa = MFMA32(kf, qf[s], sa); } \
    float a[16]; \
    _Pragma("unroll") for (int r = 0; r < 16; ++r) { \
        const float z2 = sa[r] * c1; \
        const bool valid = !diag || (32 * (KB) + (r & 3) + 8 * (r >> 2) + 4 * hi) < qpos; \
        const float sp = fmaxf(z2, 0.f) + __builtin_amdgcn_logf(1.0f + __builtin_amdgcn_exp2f(-fabsf(z2))); \
        a[r] = valid ? -sp : 0.f; \
        sa[r] = valid ? z2 : -1e30f; } \
    const float G0 = (a[0] + a[1]) + (a[2] + a[3]), G1 = (a[4] + a[5]) + (a[6] + a[7]), G2 = (a[8] + a[9]) + (a[10] + a[11]), G3 = (a[12] + a[13]) + (a[14] + a[15]); \
    const float X0 = __shfl_xor(G0, 32), X1 = __shfl_xor(G1, 32), X2 = __shfl_xor(G2, 32), X3 = __shfl_xor(G3, 32); \
    const float ab2 = G3 + X3, ab1 = ab2 + (G2 + X2), ab0 = ab1 + (G1 + X1), tot = ab0 + (G0 + X0); \
    float off[4]; off[3] = carry + (hi == 0 ? X3 : 0.f); off[2] = carry + ab2 + (hi == 0 ? X2 : 0.f); off[1] = carry + ab1 + (hi == 0 ? X1 : 0.f); off[0] = carry + ab0 + (hi == 0 ? X0 : 0.f); \
    _Pragma("unroll") for (int g = 0; g < 4; ++g) { \
        const float s3 = off[g], s2 = s3 + a[4 * g + 3], s1_ = s2 + a[4 * g + 2], s0_ = s1_ + a[4 * g + 1]; \
        sa[4 * g + 3] = __builtin_amdgcn_exp2f(sa[4 * g + 3] + a[4 * g + 3] + s3); sa[4 * g + 2] = __builtin_amdgcn_exp2f(sa[4 * g + 2] + a[4 * g + 2] + s2); \
        sa[4 * g + 1] = __builtin_amdgcn_exp2f(sa[4 * g + 1] + a[4 * g + 1] + s1_); sa[4 * g] = __builtin_amdgcn_exp2f(sa[4 * g] + a[4 * g] + s0_); } \
    carry += tot; \
    pv_block(o0, o1, sa, vt, (KB), lane); } while (0)

__device__ __forceinline__ void sb_item(const GAS bf16* __restrict__ H, GAS float* __restrict__ Yraw, LAS unsigned char* lds, int b, int chunk, int h, int qh, int wave, int lane) {
    const int r32 = lane & 31, hi = lane >> 5;
    const size_t row0 = (size_t)b * SEQ + chunk * 64;
    LAS unsigned char* vt = lds + MX_V + wave * MX_VW;
    bf16x8 qf[4];
#pragma unroll
    for (int s = 0; s < 4; ++s) qf[s] = *(const GAS bf16x8*)(H + (row0 + 32 * qh + r32) * DIN + C_QS + h * 64 + 16 * s + 8 * hi);
    f32x16 o0 = {}, o1 = {};
    float carry = 0.f;
    const float c1 = 0.125f * LOG2E;
    const int qpos = 32 * qh + r32;
    for (int kt = chunk; kt >= 0; --kt) {
        const size_t krow0 = (size_t)b * SEQ + (size_t)kt * 64;
        const bool diag = kt == chunk;
        stage_v(H + krow0 * DIN + C_VS + h * 64, vt, lane);
        if (!(diag && qh == 0)) SB_BLOCK(1);
        SB_BLOCK(0);
        if (__all(carry < -151.0f)) break;
    }
    store_ot(Yraw + (row0 + 32 * qh + r32) * D + 640 + h * 64, o0, o1, 1.0f, (LAS float*)(lds + MX_SSQ) + (32 * qh + r32) * 4 + 2, lane);
}

__device__ MIXER_INLINE void mixer_unit(LAS unsigned char* lds, const GAS bf16* __restrict__ H, GAS float* __restrict__ Yraw, GAS bf16* __restrict__ Yb,
                                           const GAS float* __restrict__ pool_w, const GAS float* __restrict__ pool_scale, const GAS float* __restrict__ rel_bias, const GAS float* __restrict__ g_mix,
                                           int b, int chunk, int tid, int wave, int lane) {
    const int t0 = chunk * 64, r32 = lane & 31, hi = lane >> 5;
    const size_t row0 = (size_t)b * SEQ + t0;
    LAS float* ssq = (LAS float*)(lds + MX_SSQ);
    if (tid < 256) ssq[tid] = 0.f;
    for (int i = tid; i < 6 * 257; i += NWAVES * 64) { const int hh = i / 257, j = i - hh * 257; ((LAS float*)(lds + MX_BIAS))[hh * 260 + j] = rel_bias[i] * LOG2E; }
    for (int i = tid; i < 80 * 32; i += NWAVES * 64) { const int r = i >> 5, ch = i & 31; v4u v = (v4u){0u, 0u, 0u, 0u};
        if (t0 - 16 + r >= 0) v = *(const GAS v4u*)(H + (row0 - 16 + r) * DIN + ch * 8);
        *(LAS v4u*)(lds + MX_U + r * 512 + ch * 16) = v; }
    __syncthreads();
    { const int c = tid & 255, th = tid >> 8, w = 2 << (c >> 6), tt0 = 32 * th;
      const LAS bf16* ucol = (const LAS bf16*)(lds + MX_U) + c;
      float s = 0.f;
      for (int k = 1; k < w; ++k) s += bf2f(ucol[(tt0 + 16 - k) * 256]);
      for (int tt = tt0; tt < tt0 + 32; ++tt) {
          const float ut = bf2f(ucol[(tt + 16) * 256]); s += ut;
          const int t = t0 + tt; const float cnt = (float)(t + 1 < w ? t + 1 : w);
          *((LAS bf16*)(lds + MX_P + tt * 528) + c) = (bf16)f2bf(s / cnt - ut);
          s -= bf2f(ucol[(tt + 17 - w) * 256]); } }
    __syncthreads();
    { const int g = wave & 3, th = wave >> 2;
      f32x16 acc0 = {}, acc1 = {};
#pragma unroll
      for (int s = 0; s < 4; ++s) {
          const bf16x8 bfr = *(const LAS bf16x8*)(lds + MX_P + (32 * th + r32) * 528 + (g * 64 + 16 * s + 8 * hi) * 2);
          v4u a0, a1; const GAS float* pw = pool_w + (size_t)(g * 64 + 16 * s + 8 * hi) * 64 + r32;
          a0.x = pk2(pw[0], pw[64]); a0.y = pk2(pw[128], pw[192]); a0.z = pk2(pw[256], pw[320]); a0.w = pk2(pw[384], pw[448]);
          a1.x = pk2(pw[32], pw[96]); a1.y = pk2(pw[160], pw[224]); a1.z = pk2(pw[288], pw[352]); a1.w = pk2(pw[416], pw[480]);
          acc0 = MFMA32(__builtin_bit_cast(bf16x8, a0), bfr, acc0); acc1 = MFMA32(__builtin_bit_cast(bf16x8, a1), bfr, acc1);
      }
#pragma unroll
      for (int r = 0; r < 16; ++r) { const int d = (r & 3) + 8 * (r >> 2) + 4 * hi; acc0[r] *= pool_scale[g * 64 + d]; acc1[r] *= pool_scale[g * 64 + 32 + d]; }
      store_ot(Yraw + (row0 + 32 * th + r32) * D + g * 64, acc0, acc1, 1.0f, ssq + (32 * th + r32) * 4 + 0, lane);
    }
    __syncthreads();
#pragma unroll 1
    for (int it = 0; it < 3; ++it) {
        const int idx = wave + 8 * it;
        if (idx < 12) chunk_item(H, Yraw, lds, b, chunk, idx >> 1, idx & 1, wave, lane);
        else sb_item(H, Yraw, lds, b, chunk, (idx - 12) >> 1, (idx - 12) & 1, wave, lane);
    }
    VM_WAIT(); __syncthreads();
#pragma unroll 1
    for (int i = 0; i < 8; ++i) {
        const int tt = wave * 8 + i;
        const float r0 = 1.0f / sqrtf(ssq[tt * 4 + 0] * (1.0f / 256.f) + RMS_EPS), r1 = 1.0f / sqrtf(ssq[tt * 4 + 1] * (1.0f / 384.f) + RMS_EPS), r2 = 1.0f / sqrtf(ssq[tt * 4 + 2] * (1.0f / 384.f) + RMS_EPS);
#pragma unroll
        for (int j = 0; j < 4; ++j) { const int col = 4 * lane + 256 * j;
            const f32x4 v = *(const GAS f32x4*)(Yraw + (row0 + tt) * D + col), gm = *(const GAS f32x4*)(g_mix + col);
            const float rr = col < 256 ? r0 : (col < 640 ? r1 : r2);
            v2u w; w.x = pk2(v[0] * rr * gm[0], v[1] * rr * gm[1]); w.y = pk2(v[2] * rr * gm[2], v[3] * rr * gm[3]);
            *(GAS v2u*)(Yb + (row0 + tt) * D + col) = w; }
    }
    __syncthreads();
}
struct Args { const float* in[18]; float* out; unsigned char* ws; int ph_lo, ph_hi; };
enum { I_X = 0, I_WIN, I_POOLW, I_POOLS, I_RELB, I_GMIX, I_WOUT, I_LN1G, I_LN1B, I_LN2G, I_LN2B, I_FWG, I_FWU, I_FWD, I_ROUTER, I_MWG, I_MWU, I_MWD };

__device__ __forceinline__ void p0_transpose_item(const float* __restrict__ W, int K, int N, bf16* __restrict__ WT, int kind, LAS float* scr, int item, int lane) {
    const int nblk = N / 32, kb = item / nblk, nb = item % nblk, k0 = 64 * kb, n0 = 32 * nb;
#pragma unroll 8
    for (int i = 0; i < 32; ++i) { const int kk = 2 * i + (lane >> 5); scr[kk * 33 + (lane & 31)] = W[(size_t)(k0 + kk) * N + n0 + (lane & 31)]; }
    LDS_WAIT(); asm volatile("" ::: "memory");
    const int drow0 = kind == 0 ? n0 : (256 * (n0 >> 7) + (n0 & 127) + (kind == 2 ? 128 : 0));
    const int c = lane & 7;
#pragma unroll
    for (int j = 0; j < 4; ++j) { const int n = (lane >> 3) + 8 * j; const LAS float* s = scr + (8 * c) * 33 + n;
        v4u o; o.x = pk2(s[0 * 33], s[1 * 33]); o.y = pk2(s[2 * 33], s[3 * 33]); o.z = pk2(s[4 * 33], s[5 * 33]); o.w = pk2(s[6 * 33], s[7 * 33]);
        *(GAS v4u*)(WT + (size_t)(drow0 + n) * K + k0 + 8 * c) = o; }
    LDS_WAIT(); asm volatile("" ::: "memory");
}
__device__ __forceinline__ void ph_prologue(const Args& a, LAS unsigned char* lds, int gw, int NGW, int wave, int lane) {
    LAS float* scr = (LAS float*)(lds + wave * 16384);
    unsigned char* ws = a.ws;
    constexpr int I_IN = (D / 64) * (DIN / 32), I_OUT = (D / 64) * (D / 32), I_F = (D / 64) * (DFF / 32);
    static_assert((DFF / 64) * (D / 32) == I_F, "item counts");
    constexpr int NITEMS = 2 * I_IN + 2 * I_OUT + 27 * I_F;
    for (int it = gw; it < NITEMS; it += NGW) {
        int r = it;
        if (r < 2 * I_IN) { const int L = r / I_IN; p0_transpose_item(a.in[I_WIN] + (size_t)L * D * DIN, D, DIN, (bf16*)(ws + WS_WIN) + (size_t)L * DIN * D, 0, scr, r % I_IN, lane); continue; }
        r -= 2 * I_IN;
        if (r < 2 * I_OUT) { const int L = r / I_OUT; p0_transpose_item(a.in[I_WOUT] + (size_t)L * D * D, D, D, (bf16*)(ws + WS_WOUT) + (size_t)L * D * D, 0, scr, r % I_OUT, lane); continue; }
        r -= 2 * I_OUT;
        const int mi = r / I_F, item = r % I_F, kind = mi % 3, grp = mi / 3;
        if (grp == 0) {
            if (kind == 0) p0_transpose_item(a.in[I_FWG], D, DFF, (bf16*)(ws + WS_WGU), 1, scr, item, lane);
            else if (kind == 1) p0_transpose_item(a.in[I_FWU], D, DFF, (bf16*)(ws + WS_WGU), 2, scr, item, lane);
            else p0_transpose_item(a.in[I_FWD], DFF, D, (bf16*)(ws + WS_WD), 0, scr, item, lane);
        } else {
            const int e = grp - 1;
            if (kind == 0) p0_transpose_item(a.in[I_MWG] + (size_t)e * D * DFF, D, DFF, (bf16*)(ws + WS_MWGU) + (size_t)e * 2 * DFF * D, 1, scr, item, lane);
            else if (kind == 1) p0_transpose_item(a.in[I_MWU] + (size_t)e * D * DFF, D, DFF, (bf16*)(ws + WS_MWGU) + (size_t)e * 2 * DFF * D, 2, scr, item, lane);
            else p0_transpose_item(a.in[I_MWD] + (size_t)e * DFF * D, DFF, D, (bf16*)(ws + WS_MWD) + (size_t)e * D * DFF, 0, scr, item, lane);
        }
    }
    const float* x = a.in[I_X]; bf16* xb = (bf16*)(ws + WS_XB);
    for (int m = gw; m < M; m += NGW) {
#pragma unroll
        for (int j = 0; j < 4; ++j) { const int col = 4 * lane + 256 * j; const f32x4 v = *(const f32x4*)(x + (size_t)m * D + col);
            v2u w; w.x = pk2(v[0], v[1]); w.y = pk2(v[2], v[3]); *(v2u*)(xb + (size_t)m * D + col) = w; }
    }
}

template <bool ROUTE>
__device__ __forceinline__ void ph_ln(const float* xi, const float* __restrict__ mf, const float* __restrict__ g, const float* __restrict__ be, float* xo, bf16* __restrict__ xb,
                                      const float* __restrict__ router, int* __restrict__ toke, float* __restrict__ tokw, int* __restrict__ cnt, LAS unsigned char* lds, int v, int G, int tid, int wave, int lane) {
    LAS int* hist = (LAS int*)lds;
    if (ROUTE) { if (tid < 8) hist[tid] = 0; __syncthreads(); }
    f32x4 gv[4], bv[4];
#pragma unroll
    for (int j = 0; j < 4; ++j) { gv[j] = *(const f32x4*)(g + 4 * lane + 256 * j); bv[j] = *(const f32x4*)(be + 4 * lane + 256 * j); }
    for (int blk = v; blk < M / 64; blk += G) {
#pragma unroll 1
        for (int i = 0; i < 8; ++i) {
            const size_t m = (size_t)blk * 64 + wave * 8 + i;
            f32x4 x[4]; float s = 0.f;
#pragma unroll
            for (int j = 0; j < 4; ++j) { const size_t o = m * D + 4 * lane + 256 * j; const f32x4 a = *(const f32x4*)(xi + o), c = *(const f32x4*)(mf + o);
                x[j] = a * ALPHA + c; s += (x[j][0] + x[j][1]) + (x[j][2] + x[j][3]); }
            const float mean = wave_sum(s) * (1.f / D); float q = 0.f;
#pragma unroll
            for (int j = 0; j < 4; ++j) { x[j] = x[j] - mean; q += (x[j][0] * x[j][0] + x[j][1] * x[j][1]) + (x[j][2] * x[j][2] + x[j][3] * x[j][3]); }
            const float rstd = 1.f / sqrtf(wave_sum(q) * (1.f / D) + LN_EPS);
#pragma unroll
            for (int j = 0; j < 4; ++j) { const size_t o = m * D + 4 * lane + 256 * j; x[j] = x[j] * rstd * gv[j] + bv[j];
                *(f32x4*)(xo + o) = x[j]; v2u w; w.x = pk2(x[j][0], x[j][1]); w.y = pk2(x[j][2], x[j][3]); *(v2u*)(xb + o) = w; }
            if (ROUTE) {
                float lg[8];
#pragma unroll
                for (int e = 0; e < 8; ++e) lg[e] = 0.f;
#pragma unroll
                for (int j = 0; j < 4; ++j)
#pragma unroll
                    for (int k = 0; k < 4; ++k) { const float* rw = router + (size_t)(4 * lane + 256 * j + k) * 8; const f32x4 r0 = *(const f32x4*)rw, r1 = *(const f32x4*)(rw + 4);
                        lg[0] += x[j][k] * r0[0]; lg[1] += x[j][k] * r0[1]; lg[2] += x[j][k] * r0[2]; lg[3] += x[j][k] * r0[3];
                        lg[4] += x[j][k] * r1[0]; lg[5] += x[j][k] * r1[1]; lg[6] += x[j][k] * r1[2]; lg[7] += x[j][k] * r1[3]; }
#pragma unroll
                for (int e = 0; e < 8; ++e) lg[e] = wave_sum(lg[e]);
                int i1 = 0; float v1 = lg[0];
#pragma unroll
                for (int e = 1; e < 8; ++e) if (lg[e] > v1) { v1 = lg[e]; i1 = e; }
                int i2 = i1 == 0 ? 1 : 0; float v2 = i1 == 0 ? lg[1] : lg[0];
#pragma unroll
                for (int e = 1; e < 8; ++e) if (e != i1 && lg[e] > v2) { v2 = lg[e]; i2 = e; }
                const float e2 = expf(v2 - v1), w1 = 1.f / (1.f + e2), w2 = e2 / (1.f + e2);
                if (lane == 0) { toke[2 * m] = i1; toke[2 * m + 1] = i2; tokw[2 * m] = w1; tokw[2 * m + 1] = w2;
                    __hip_atomic_fetch_add(hist + i1, 1, __ATOMIC_RELAXED, __HIP_MEMORY_SCOPE_WORKGROUP); __hip_atomic_fetch_add(hist + i2, 1, __ATOMIC_RELAXED, __HIP_MEMORY_SCOPE_WORKGROUP); }
            }
        }
    }
    if (ROUTE) { __syncthreads(); if (tid < 8) cnt[v * 8 + tid] = hist[tid]; __syncthreads(); }
}

__device__ __forceinline__ void moe_offsets(const int* __restrict__ cnt, int v, int lane, int (&offs)[9], int (&before)[8]) {
    int tot[8], bef[8];
#pragma unroll
    for (int e = 0; e < 8; ++e) { tot[e] = 0; bef[e] = 0; }
#pragma unroll
    for (int i = 0; i < 4; ++i) { const int w = 4 * lane + i; const int* p = cnt + w * 8;
#pragma unroll
        for (int e = 0; e < 8; ++e) { const int c = p[e]; tot[e] += c; bef[e] += (w < v) ? c : 0; } }
#pragma unroll
    for (int e = 0; e < 8; ++e) {
#pragma unroll
        for (int o = 1; o < 64; o <<= 1) { tot[e] += __shfl_xor(tot[e], o); bef[e] += __shfl_xor(bef[e], o); } }
    int run = 0;
#pragma unroll
    for (int e = 0; e < 8; ++e) { offs[e] = run; before[e] = bef[e]; run += (tot[e] + 255) & ~255; }
    offs[8] = run;
}
__device__ __forceinline__ void ph_assign(const int* __restrict__ cnt, const int* __restrict__ toke, int* __restrict__ toks, const bf16* __restrict__ xb, bf16* __restrict__ xperm,
                                          LAS unsigned char* lds, int v, int tid, int wave, int lane) {
    LAS int* slotl = (LAS int*)lds;
    if (wave == 0) {
        int offs[9], before[8]; moe_offsets(cnt, v, lane, offs, before);
        const int t = v * 64 + lane, e1 = toke[2 * t], e2 = toke[2 * t + 1];
        int s1 = 0, s2 = 0;
        const unsigned long long lt = (1ull << lane) - 1ull;
#pragma unroll
        for (int e = 0; e < 8; ++e) {
            const unsigned long long m0 = __ballot(e1 == e), m1 = __ballot(e2 == e);
            const int base = offs[e] + before[e];
            if (e1 == e) s1 = base + __popcll(m0 & lt);
            if (e2 == e) s2 = base + __popcll(m0) + __popcll(m1 & lt);
        }
        toks[2 * t] = s1; toks[2 * t + 1] = s2; slotl[2 * lane] = s1; slotl[2 * lane + 1] = s2;
    }
    __syncthreads();
#pragma unroll 1
    for (int i = 0; i < 16; ++i) { const int p = wave * 16 + i, tt = p >> 1; const int slot = slotl[p];
        const bf16* src = xb + (size_t)(v * 64 + tt) * D; bf16* dst = xperm + (size_t)slot * D;
        const v4u a = *(const v4u*)(src + 8 * lane), b = *(const v4u*)(src + 512 + 8 * lane);
        *(v4u*)(dst + 8 * lane) = a; *(v4u*)(dst + 512 + 8 * lane) = b; }
    __syncthreads();
}
__device__ __forceinline__ void ph_combine(const float* xi, const bf16* __restrict__ yperm, const int* __restrict__ toks, const float* __restrict__ tokw, const float* __restrict__ g, const float* __restrict__ be,
                                           float* xo, int gw, int NGW, int lane) {
    f32x4 gv[4], bv[4];
#pragma unroll
    for (int j = 0; j < 4; ++j) { gv[j] = *(const f32x4*)(g + 4 * lane + 256 * j); bv[j] = *(const f32x4*)(be + 4 * lane + 256 * j); }
    for (int m = gw; m < M; m += NGW) {
        const int s1 = toks[2 * m], s2 = toks[2 * m + 1]; const float w1 = tokw[2 * m], w2 = tokw[2 * m + 1];
        f32x4 x[4]; float s = 0.f;
#pragma unroll
        for (int j = 0; j < 4; ++j) { const int col = 4 * lane + 256 * j; const f32x4 a = *(const f32x4*)(xi + (size_t)m * D + col);
            const v2u y1 = *(const v2u*)(yperm + (size_t)s1 * D + col), y2 = *(const v2u*)(yperm + (size_t)s2 * D + col);
            x[j][0] = a[0] * ALPHA + w1 * bflo(y1.x) + w2 * bflo(y2.x); x[j][1] = a[1] * ALPHA + w1 * bfhi(y1.x) + w2 * bfhi(y2.x);
            x[j][2] = a[2] * ALPHA + w1 * bflo(y1.y) + w2 * bflo(y2.y); x[j][3] = a[3] * ALPHA + w1 * bfhi(y1.y) + w2 * bfhi(y2.y);
            s += (x[j][0] + x[j][1]) + (x[j][2] + x[j][3]); }
        const float mean = wave_sum(s) * (1.f / D); float q = 0.f;
#pragma unroll
        for (int j = 0; j < 4; ++j) { x[j] = x[j] - mean; q += (x[j][0] * x[j][0] + x[j][1] * x[j][1]) + (x[j][2] * x[j][2] + x[j][3] * x[j][3]); }
        const float rstd = 1.f / sqrtf(wave_sum(q) * (1.f / D) + LN_EPS);
#pragma unroll
        for (int j = 0; j < 4; ++j) *(f32x4*)(xo + (size_t)m * D + 4 * lane + 256 * j) = x[j] * rstd * gv[j] + bv[j];
    }
}
constexpr int N_PHASES = 16;
__global__ void __launch_bounds__(NWAVES * 64, 2) mk_fwd(Args a) {
    extern __shared__ __attribute__((aligned(16))) unsigned char lds_raw[];
    LAS unsigned char* lds = (LAS unsigned char*)lds_raw;
    const int tid = threadIdx.x, lane = tid & 63, wave = __builtin_amdgcn_readfirstlane(tid >> 6);
    const int G = gridDim.x, bx = blockIdx.x;
    const int vcu = (G % 8 == 0) ? (bx % 8) * (G / 8) + bx / 8 : bx;
    const int gw = vcu * NWAVES + wave, NGW = G * NWAVES;
    unsigned char* ws = a.ws;
    gu32* ctl = (gu32*)(ws + WS_CTL);
    for (int u = tid; u < (LDS_BYTES - LDSCTL_OFF) / 4; u += NWAVES * 64) ((LAS unsigned*)(lds + LDSCTL_OFF))[u] = 0u;
    __syncthreads();
    const int lo = a.ph_lo, hi = a.ph_hi;
    XcdBarrier bar; bar.bar = (unsigned*)(ctl + CW_BAR); bar.x = 0; bar.st = nullptr;
    if (hi - lo > 1) bar = xcd_barrier_post((unsigned*)(ctl + CW_BAR), (volatile LAS unsigned*)(lds + MISC_OFF) + 8);
#define IN(k) (lo <= (k) && (k) < hi)
#define SEAM(k) do { if (IN(k) && IN((k) + 1)) xcd_barrier(bar); } while (0)
    bf16* const XB = (bf16*)(ws + WS_XB); bf16* const HB = (bf16*)(ws + WS_HB); bf16* const YB = (bf16*)(ws + WS_YB); float* const MF = (float*)(ws + WS_MF);
    float* const X = a.out;
    int* const toke = (int*)(ws + WS_TOKE); float* const tokw = (float*)(ws + WS_TOKW); int* const toks = (int*)(ws + WS_TOKS); int* const cnt = (int*)(ws + WS_CNT);

    if (IN(0)) { ph_prologue(a, lds, gw, NGW, wave, lane); SEAM(0); }

#define LAYER_BODY(L) do { \
        const int pb = 1 + 7 * L; \
          \
        if (IN(pb)) { \
            pg8::Gemm g{XB, (const pg8::bf16_t*)(ws + WS_WIN) + (size_t)L * DIN * D, M, DIN, D}; pg8::StaticOrder S; S.init(M, DIN, G, bx); \
            pg8::EpiStoreBf16P E{HB, DIN, DIN / 256}; \
            pg8::gemm_phase<pg8::EpiStoreBf16P, pg8::StaticOrder, PG8_ALIGN, PG8_SP2>(lds + RING_OFF, g, S, E); \
            SEAM(pb); \
        } \
          \
        if (IN(pb + 1)) { \
            { const int u = vcu;   \
                mixer_unit(lds, (const GAS bf16*)HB, (GAS float*)MF, (GAS bf16*)YB, (const GAS float*)(a.in[I_POOLW] + L * 4 * 64 * 64), (const GAS float*)(a.in[I_POOLS] + L * 256), (const GAS float*)(a.in[I_RELB] + L * 6 * 257), (const GAS float*)(a.in[I_GMIX] + L * D), u >> 6, u & 63, tid, wave, lane); } \
            SEAM(pb + 1); \
        } \
          \
        if (IN(pb + 2)) { \
            pg8::Gemm g{YB, (const pg8::bf16_t*)(ws + WS_WOUT) + (size_t)L * D * D, M, D, D}; pg8::StaticOrder S; S.init(M, D, G, bx); \
            pg8::EpiF32 E{MF, D, 0}; \
            pg8::gemm_phase<pg8::EpiF32, pg8::StaticOrder, PG8_ALIGN, PG8_SP2>(lds + RING_OFF, g, S, E); \
            SEAM(pb + 2); \
        } \
          \
        if (IN(pb + 3)) { \
            const float* xi = L == 0 ? a.in[I_X] : X; \
            if (L == 0) ph_ln<false>(xi, MF, a.in[I_LN1G] + L * D, a.in[I_LN1B] + L * D, X, XB, nullptr, nullptr, nullptr, nullptr, lds, vcu, G, tid, wave, lane); \
            else ph_ln<true>(xi, MF, a.in[I_LN1G] + L * D, a.in[I_LN1B] + L * D, X, XB, a.in[I_ROUTER], toke, tokw, cnt, lds, vcu, G, tid, wave, lane); \
            SEAM(pb + 3); \
        } \
        if (L == 0) { \
            if (IN(5)) {     \
                pg8::Gemm g{XB, (const pg8::bf16_t*)(ws + WS_WGU), M, 2 * DFF, D}; pg8::StaticOrder S; S.init(M, 2 * DFF, G, bx); \
                pg8::EpiSwiGLU E{HB, DFF, 2 * DFF / 256}; \
                pg8::gemm_phase<pg8::EpiSwiGLU, pg8::StaticOrder, PG8_ALIGN, PG8_SP2>(lds + RING_OFF, g, S, E); \
                SEAM(5); \
            } \
            if (IN(6)) {     \
                pg8::Gemm g{HB, (const pg8::bf16_t*)(ws + WS_WD), M, D, DFF}; pg8::StaticOrder S; S.init(M, D, G, bx); \
                pg8::EpiF32 E{MF, D, 0}; \
                pg8::gemm_phase<pg8::EpiF32, pg8::StaticOrder, PG8_ALIGN, PG8_SP2>(lds + RING_OFF, g, S, E); \
                SEAM(6); \
            } \
            if (IN(7)) { ph_ln<false>(X, MF, a.in[I_LN2G], a.in[I_LN2B], X, XB, nullptr, nullptr, nullptr, nullptr, lds, vcu, G, tid, wave, lane); SEAM(7); } \
        } else { \
            if (IN(12)) { ph_assign(cnt, toke, toks, XB, (bf16*)(ws + WS_XPERM), lds, vcu, tid, wave, lane); SEAM(12); } \
            if (IN(13) || IN(14)) { \
                int offs[9], before[8]; moe_offsets(cnt, 0, lane, offs, before); \
                pg8::GroupedOrder S; \
_Pragma("unroll") for (int e = 0; e < 9; ++e) S.ts[e] = __builtin_amdgcn_readfirstlane(offs[e]) >> 8; \
                const int nT = S.ts[8]; \
                if (IN(13)) {     \
                    S.npn = 2 * DFF / 256; S.so.init(nT * 256, 2 * DFF, G, bx); \
                    pg8::Gemm g{(const pg8::bf16_t*)(ws + WS_XPERM), (const pg8::bf16_t*)(ws + WS_MWGU), nT * 256, 2 * DFF, D}; \
                    pg8::EpiSwiGLU E{(pg8::bf16_t*)(ws + WS_HPERM), DFF, 2 * DFF / 256}; \
                    pg8::gemm_phase<pg8::EpiSwiGLU, pg8::GroupedOrder, PG8_ALIGN, PG8_SP2>(lds + RING_OFF, g, S, E); \
                    SEAM(13); \
                } \
                if (IN(14)) {     \
                    S.npn = D / 256; S.so.init(nT * 256, D, G, bx); \
                    pg8::Gemm g{(const pg8::bf16_t*)(ws + WS_HPERM), (const pg8::bf16_t*)(ws + WS_MWD), nT * 256, D, DFF}; \
                    pg8::EpiStoreBf16P E{(pg8::bf16_t*)(ws + WS_YPERM), D, D / 256}; \
                    pg8::gemm_phase<pg8::EpiStoreBf16P, pg8::GroupedOrder, PG8_ALIGN, PG8_SP2>(lds + RING_OFF, g, S, E); \
                    SEAM(14); \
                } \
            } \
            if (IN(15)) ph_combine(X, (const bf16*)(ws + WS_YPERM), toks, tokw, a.in[I_LN2G] + D, a.in[I_LN2B] + D, X, gw, NGW, lane); \
        } \
    } while (0)
    LAYER_BODY(0);
    LAYER_BODY(1);
#undef LAYER_BODY
#undef IN
#undef SEAM
}
#ifndef DEV_MASK
#define DEV_MASK 0x3f
#endif
#ifndef ONE_LAUNCH
#define ONE_LAUNCH 1
#endif
static void launch_mk(Args a, int lo, int hi, int grid, hipStream_t s) { a.ph_lo = lo; a.ph_hi = hi; hipLaunchKernelGGL(mk_fwd, dim3(grid), dim3(NWAVES * 64), LDS_BYTES, s, a); }

extern "C" void kernel_launch(void* const* d_in, const int* in_sizes, int n_in, void* d_out, int out_size, void* d_ws, size_t ws_size, hipStream_t stream) {
    static int grid = 0;
    if (grid == 0) {
        if (n_in != 18 || in_sizes[0] != M * D || out_size != M * D || ws_size < WS_END) { fprintf(stderr, "kernel_launch: unexpected shapes / workspace (%d inputs, ws %zu < %zu)\n", n_in, ws_size, (size_t)WS_END); grid = -1; return; }
        int dev = 0, cus = 0, per_cu = 0;
        if (hipGetDevice(&dev) != hipSuccess || hipDeviceGetAttribute(&cus, hipDeviceAttributeMultiprocessorCount, dev) != hipSuccess) { grid = -1; return; }
        if (hipFuncSetAttribute((const void*)mk_fwd, hipFuncAttributeMaxDynamicSharedMemorySize, LDS_BYTES) != hipSuccess) { fprintf(stderr, "kernel_launch: hipFuncSetAttribute failed\n"); grid = -1; return; }
        if (hipOccupancyMaxActiveBlocksPerMultiprocessor(&per_cu, (const void*)mk_fwd, NWAVES * 64, LDS_BYTES) != hipSuccess || per_cu < 1) { fprintf(stderr, "kernel_launch: occupancy query says %d blocks per CU\n", per_cu); }
        (void)hipGetLastError();
        grid = cus;
        if (grid != 256) { fprintf(stderr, "kernel_launch: built for 256 CUs, device has %d\n", cus); grid = -1; return; }
    }
    if (grid < 0) return;
    (void)hipMemsetAsync((char*)d_ws + WS_CTL, 0, CTL_ZERO_BYTES, stream);
    Args a{};
    for (int i = 0; i < 18; ++i) a.in[i] = (const float*)d_in[i];
    a.out = (float*)d_out; a.ws = (unsigned char*)d_ws;
#if ONE_LAUNCH
    launch_mk(a, 0, N_PHASES, grid, stream);
#else
    unsigned char* ws = (unsigned char*)d_ws;
    float* X = (float*)d_out; bf16* Xb = (bf16*)(ws + WS_XB); bf16* H = (bf16*)(ws + WS_HB); bf16* Yb = (bf16*)(ws + WS_YB); float* Mf = (float*)(ws + WS_MF);
    float* pooled = (float*)(ws + WS_YB); float* gates = (float*)(ws + WS_GATES);
    const float* x = a.in[I_X];
    launch_mk(a, 0, 1, grid, stream);
    for (int L = 0; L < 2; ++L) {
        const int pb = 1 + 7 * L;
        if (DEV_MASK & 1) launch_mk(a, pb, pb + 1, grid, stream);
        else gemm_simple<false, EpiStoreBf16><<<dim3(DIN / 128, M / 128), 256, 0, stream>>>(Xb, D, a.in[I_WIN] + (size_t)L * D * DIN, nullptr, DIN, D, EpiStoreBf16{H, DIN, 0});
        if (DEV_MASK & 2) launch_mk(a, pb + 1, pb + 2, grid, stream);
        else {
            pool_a<<<M * 256 / 256, 256, 0, stream>>>(H, pooled);
            pool_b<<<M * 256 / 256, 256, 0, stream>>>(pooled, a.in[I_POOLW] + L * 4 * 64 * 64, a.in[I_POOLS] + L * 256, Mf);
            chunk_attn_naive<<<M * 6 / 4, 256, 0, stream>>>(H, a.in[I_RELB] + L * 6 * 257, Mf);
            sb_attn_naive<<<M * 6 / 4, 256, 0, stream>>>(H, Mf);
            rms_cat<<<M / 4, 256, 0, stream>>>(Mf, a.in[I_GMIX] + L * D, Yb);
        }
        if (DEV_MASK & 4) launch_mk(a, pb + 2, pb + 3, grid, stream);
        else gemm_simple<false, EpiStoreF32><<<dim3(D / 128, M / 128), 256, 0, stream>>>(Yb, D, a.in[I_WOUT] + (size_t)L * D * D, nullptr, D, D, EpiStoreF32{Mf, D, 0});
        const bool mk_moe = (DEV_MASK & 32) != 0;
        if ((L == 0 && (DEV_MASK & 8)) || (L == 1 && mk_moe)) launch_mk(a, pb + 3, pb + 4, grid, stream);
        else ln_res<<<M / 4, 256, 0, stream>>>(L == 0 ? x : X, Mf, a.in[I_LN1G] + L * D, a.in[I_LN1B] + L * D, X, Xb);
        if (L == 0) {
            if (DEV_MASK & 16) { launch_mk(a, 5, 6, grid, stream); launch_mk(a, 6, 7, grid, stream); }
            else {
                gemm_simple<true, EpiSwiglu><<<dim3(DFF / 128, M / 128), 256, 0, stream>>>(Xb, D, a.in[I_FWG], a.in[I_FWU], DFF, D, EpiSwiglu{H, DFF, 0});
                gemm_simple<false, EpiStoreF32><<<dim3(D / 128, M / 128), 256, 0, stream>>>(H, DFF, a.in[I_FWD], nullptr, D, DFF, EpiStoreF32{Mf, D, 0});
            }
            if (DEV_MASK & 8) launch_mk(a, 7, 8, grid, stream);
            else ln_res<<<M / 4, 256, 0, stream>>>(X, Mf, a.in[I_LN2G], a.in[I_LN2B], X, Xb);
        } else if (mk_moe) {
            for (int p = 12; p < 16; ++p) launch_mk(a, p, p + 1, grid, stream);
        } else {
            router_naive<<<M / 4, 256, 0, stream>>>(X, a.in[I_ROUTER], gates);
            for (int e = 0; e < NEXP; ++e) {
                gemm_simple<true, EpiSwiglu><<<dim3(DFF / 128, M / 128), 256, 0, stream>>>(Xb, D, a.in[I_MWG] + (size_t)e * D * DFF, a.in[I_MWU] + (size_t)e * D * DFF, DFF, D, EpiSwiglu{H, DFF, 0});
                gemm_simple<false, EpiMoeAcc><<<dim3(D / 128, M / 128), 256, 0, stream>>>(H, DFF, a.in[I_MWD] + (size_t)e * DFF * D, nullptr, D, DFF, EpiMoeAcc{Mf, gates, e, 0});
            }
            ln_res<<<M / 4, 256, 0, stream>>>(X, Mf, a.in[I_LN2G] + D, a.in[I_LN2B] + D, X, Xb);
        }
    }
#endif
}
```

```cpp
#include <hip/hip_runtime.h>
#include <hip/hip_bf16.h>
#include <cstdio>
#include <cstdint>
#include <math.h>
#define ONE_LAUNCH 1
#define DEV_MASK 0x3f
namespace pg8 {
#define PG8_LAS __attribute__((address_space(3)))
typedef unsigned short bf16_t;
typedef short bf16x8 __attribute__((ext_vector_type(8)));
typedef float f32x4 __attribute__((ext_vector_type(4)));
typedef unsigned u32x4 __attribute__((ext_vector_type(4)));
constexpr int BM = 256, BK = 64, HALF = 128, HTB = HALF * BK * 2  , STAGE_BYTES = 8 * HTB, NXCD = 8, WGM = 8;

__host__ __device__ __forceinline__ int lds_byte(int r, int c) { const int st = (r >> 4) * 2 + (c >> 5), rr = r & 15, cc = c & 31, ob = rr * 64 + cc * 2; return st * 1024 + (ob ^ (((ob >> 9) & 1) << 5)); }
__host__ __device__ __forceinline__ void stage_rc(int b, int& R, int& C) { const int st = b / 1024, sb = b % 1024, swz = sb ^ (((sb >> 9) & 1) << 5); R = (st >> 1) * 16 + swz / 64; C = (st & 1) * 32 + (swz % 64) / 2; }
__host__ __device__ __forceinline__ int perm32(int rho) { const int n = rho >> 4, i = rho & 15; return 8 * (i >> 2) + 4 * n + (i & 3); }

struct Unit { int pm, pn; };
struct Gemm { const bf16_t* A; const bf16_t* Bt; int M, N, K; };

struct StaticOrder {
    int nM, nN, nwg, G, c;
    __host__ __device__ void init(int M, int N, int G_, int c_) { nM = M / BM; nN = N / BM; nwg = nM * nN; G = G_; c = c_; }
    __host__ __device__ bool next(int i, Unit& u) const {
        const long L = (long)i * G + c; if (L >= nwg) return false;
        int wgid = (int)L; { const int q = nwg / NXCD, r = nwg % NXCD, xcd = wgid % NXCD, off = wgid / NXCD; wgid = (xcd < r ? xcd * (q + 1) : r * (q + 1) + (xcd - r) * q) + off; }
        const int nig = WGM * nN, gid = wgid / nig, fm = gid * WGM, gsz = (nM - fm) < WGM ? (nM - fm) : WGM;
        u.pm = fm + ((wgid % nig) % gsz); u.pn = (wgid % nig) / gsz; return true;
    }
    __device__ __forceinline__ void a_ready(const Unit&) const {}
    __device__ __forceinline__ void done(const Unit&) const {}
};

__device__ __forceinline__ unsigned cvt_pk_bf16(float lo, float hi) { unsigned r; asm volatile("v_cvt_pk_bf16_f32 %0, %1, %2" : "=v"(r) : "v"(lo), "v"(hi)); return r; }
typedef float f32x2 __attribute__((ext_vector_type(2)));
__device__ __forceinline__ f32x2 gelu_pk(f32x2 v) {
    const f32x2 av = __builtin_elementwise_abs(v), d = av * 0.2316418882f + 1.0f;
    f32x2 t; t.x = __builtin_amdgcn_rcpf(d.x); t.y = __builtin_amdgcn_rcpf(d.y);
    f32x2 q = t * 0.5307027145f + (-0.7265760135f); q = q * t + 0.7107068705f; q = q * t + (-0.142248368f); q = q * t + 0.127414796f; q = q * t;
    const f32x2 s = (v * v) * (-0.72134752044f);
    f32x2 e; e.x = __builtin_amdgcn_exp2f(s.x); e.y = __builtin_amdgcn_exp2f(s.y);
    const f32x2 m = v * (q * e), r = v - m;
    f32x2 o; o.x = v.x < 0.f ? m.x : r.x; o.y = v.y < 0.f ? m.y : r.y; return o;
}

template <int ACT  > struct EpiBf16 {
    static constexpr bool PERM = true, AFTER_DRAIN = false; static_assert(ACT == 0 || ACT == 1, "EpiBf16: ACT is 0 (none) or 1 (gelu_pk)");
    bf16_t* O; int ldc; const float* bias; int split_cols; size_t split_stride; float scale0;
    __device__ __forceinline__ void operator()(const f32x4 (&acc)[2][2][4][2], const Unit& u, int wr, int wc, int fr, int fq) const {
        const int row0 = u.pm * BM + wr * 64 + fr; int colt = u.pn * BM; bf16_t* base = O;
        float sc = 1.f; if (split_cols) { const int t = colt / split_cols; base += (size_t)t * split_stride; colt -= t * split_cols; if (t == 0) sc = scale0; }
        const int col0 = colt + wc * 32 + 8 * fq, bcol0 = u.pn * BM + wc * 32 + 8 * fq;
        f32x4 bv[2][2];
#pragma unroll
        for (int bj = 0; bj < 2; ++bj)
#pragma unroll
            for (int n = 0; n < 2; ++n) bv[bj][n] = bias ? *(const f32x4*)(bias + bcol0 + bj * HALF + 4 * n) : (f32x4){0.f, 0.f, 0.f, 0.f};
#pragma unroll
        for (int ai = 0; ai < 2; ++ai)
#pragma unroll
            for (int m = 0; m < 4; ++m) { bf16_t* rowp = base + (size_t)(row0 + ai * HALF + m * 16) * ldc + col0;
#pragma unroll
                for (int bj = 0; bj < 2; ++bj) { f32x4 v0 = acc[ai][bj][m][0] + bv[bj][0], v1 = acc[ai][bj][m][1] + bv[bj][1];
                    if (ACT == 1) { f32x2 a = gelu_pk((f32x2){v0[0], v0[1]}), b = gelu_pk((f32x2){v0[2], v0[3]}), c = gelu_pk((f32x2){v1[0], v1[1]}), d = gelu_pk((f32x2){v1[2], v1[3]});
                        v0 = (f32x4){a.x, a.y, b.x, b.y}; v1 = (f32x4){c.x, c.y, d.x, d.y}; }
                    v0 = v0 * sc; v1 = v1 * sc; u32x4 w; w.x = cvt_pk_bf16(v0[0], v0[1]); w.y = cvt_pk_bf16(v0[2], v0[3]); w.z = cvt_pk_bf16(v1[0], v1[1]); w.w = cvt_pk_bf16(v1[2], v1[3]);
                    *(u32x4*)(rowp + bj * HALF) = w; } }
    }
};

struct PanelStats {
    unsigned* xbuf;
    unsigned* cnt;
    unsigned* tmo;
    int ntn; float eps;
    unsigned code;
    __device__ __forceinline__ bool run(const f32x4 (&v)[2][2][4][2], const Unit& u, int wr, int wc, int fr, int fq, PG8_LAS unsigned char* lds, int wid, int lane) const {
        typedef float f32x2v __attribute__((ext_vector_type(2)));
        PG8_LAS f32x2v* P = (PG8_LAS f32x2v*)lds;
        PG8_LAS f32x2v* S = (PG8_LAS f32x2v*)(lds + 8192);
        PG8_LAS unsigned* flag = (PG8_LAS unsigned*)(lds + 8192 + 2048);
#pragma unroll
        for (int ai = 0; ai < 2; ++ai)
#pragma unroll
            for (int m = 0; m < 4; ++m) {
                float s = 0.f;
#pragma unroll
                for (int bj = 0; bj < 2; ++bj)
#pragma unroll
                    for (int n = 0; n < 2; ++n) { const f32x4 x = v[ai][bj][m][n]; s += (x[0] + x[1]) + (x[2] + x[3]); }
                s += __shfl_xor(s, 16); s += __shfl_xor(s, 32);
                const float mw = s * (1.0f / 64.0f); float q = 0.f;
#pragma unroll
                for (int bj = 0; bj < 2; ++bj)
#pragma unroll
                    for (int n = 0; n < 2; ++n) { const f32x4 d = v[ai][bj][m][n] - mw; q += (d[0] * d[0] + d[1] * d[1]) + (d[2] * d[2] + d[3] * d[3]); }
                q += __shfl_xor(q, 16); q += __shfl_xor(q, 32);
                if (fq == 0) P[(ai * HALF + wr * 64 + m * 16 + fr) * 4 + wc] = (f32x2v){mw, q};
            }
        asm volatile("s_waitcnt lgkmcnt(0)" ::: "memory"); __builtin_amdgcn_s_barrier(); asm volatile("" ::: "memory");
#if defined(BROKEN_EXCHANGE_NO_WAIT)
#warning BROKEN CONTROL BUILD: the row-statistics exchange does not wait; results are wrong by design
        if (blockIdx.x >= 64) { const long long t0_ = clock64(); while (clock64() - t0_ < 60000) __builtin_amdgcn_s_sleep(8); }
#endif
        const int row = wid * 32 + (lane & 31);
        if (lane < 32) {
            const f32x2v a = P[row * 4 + 0], b = P[row * 4 + 1], c = P[row * 4 + 2], d = P[row * 4 + 3];
            const float mt = (a.x + b.x + c.x + d.x) * 0.25f;
            const float da = a.x - mt, db = b.x - mt, dc = c.x - mt, dd = d.x - mt;
            const float m2 = (a.y + b.y) + (c.y + d.y) + 64.0f * ((da * da + db * db) + (dc * dc + dd * dd));
            unsigned long long* slot = (unsigned long long*)xbuf + ((size_t)(u.pm * BM + row) * 4 + u.pn);
            __hip_atomic_store(slot, ((unsigned long long)__float_as_uint(m2) << 32) | __float_as_uint(mt), __ATOMIC_RELAXED, __HIP_MEMORY_SCOPE_AGENT);
        }
        asm volatile("s_waitcnt vmcnt(0)" ::: "memory");
        if (lane == 0) __hip_atomic_fetch_add(cnt + 64 * u.pm, 1u, __ATOMIC_RELAXED, __HIP_MEMORY_SCOPE_AGENT);
        if (wid == 0) {
            bool dead = false; const unsigned long long t0 = __builtin_amdgcn_s_memrealtime(); const unsigned want = 8u * (unsigned)ntn;
            for (;;) {
#if defined(BROKEN_EXCHANGE_NO_WAIT)
                break;
#endif
                if ((unsigned)__builtin_amdgcn_readfirstlane(__hip_atomic_load(cnt + 64 * u.pm, __ATOMIC_RELAXED, __HIP_MEMORY_SCOPE_AGENT)) >= want) break;
                if (__builtin_amdgcn_s_memrealtime() - t0 > 2000000ull) {
                    if (lane == 0) { unsigned expect = 0u; __hip_atomic_compare_exchange_strong(tmo + 1, &expect, code | (unsigned)(u.pm & 0xff), __ATOMIC_RELAXED, __ATOMIC_RELAXED, __HIP_MEMORY_SCOPE_AGENT);
                                     __hip_atomic_store(tmo, 1u, __ATOMIC_RELAXED, __HIP_MEMORY_SCOPE_AGENT); }
                    dead = true; break; }
                __builtin_amdgcn_s_sleep(2);
            }
            __builtin_amdgcn_fence(__ATOMIC_ACQUIRE, "agent");
            if (lane == 0) flag[0] = dead ? 1u : 0u;
        }
        asm volatile("s_waitcnt vmcnt(0) lgkmcnt(0)" ::: "memory"); __builtin_amdgcn_s_barrier(); asm volatile("" ::: "memory");
        const bool bad = flag[0] != 0u;
        if (lane < 32) {
            const unsigned long long* slot = (const unsigned long long*)xbuf + (size_t)(u.pm * BM + row) * 4; float mt[4], m2[4]; float ms = 0.f;
#pragma unroll
            for (int t = 0; t < 4; ++t) { if (t < ntn) { const unsigned long long w = __hip_atomic_load(slot + t, __ATOMIC_RELAXED, __HIP_MEMORY_SCOPE_AGENT); mt[t] = __uint_as_float((unsigned)w); m2[t] = __uint_as_float((unsigned)(w >> 32)); } else { mt[t] = 0.f; m2[t] = 0.f; } ms += mt[t]; }
            const float mean = ms / (float)ntn; float q = 0.f;
#pragma unroll
            for (int t = 0; t < 4; ++t) if (t < ntn) { const float dm = mt[t] - mean; q += m2[t] + 256.0f * dm * dm; }
            S[row] = (f32x2v){mean, 1.0f / sqrtf(q / (256.0f * (float)ntn) + eps)};
        }
        asm volatile("s_waitcnt lgkmcnt(0)" ::: "memory"); __builtin_amdgcn_s_barrier(); asm volatile("" ::: "memory");
        return bad;
    }
};
struct EpiLnRes {
    static constexpr bool PERM = false, AFTER_DRAIN = true;
    const float* base; float* out; int ldc; const float* bias; PanelStats st; unsigned poison;
    __device__ __forceinline__ void fused(f32x4 (&acc)[2][2][4][2], const Unit& u, int wr, int wc, int fr, int fq, PG8_LAS unsigned char* lds, int wid, int lane) const {
        typedef float f32x2v __attribute__((ext_vector_type(2)));
        const PG8_LAS f32x2v* S = (const PG8_LAS f32x2v*)(lds + 8192);
        const int col0 = u.pn * BM + wc * 32 + 4 * fq;
#pragma unroll
        for (int bj = 0; bj < 2; ++bj)
#pragma unroll
            for (int n = 0; n < 2; ++n) { const f32x4 bv = bias ? *(const f32x4*)(bias + col0 + bj * HALF + n * 16) : (f32x4){0.f, 0.f, 0.f, 0.f};
#pragma unroll
                for (int ai = 0; ai < 2; ++ai)
#pragma unroll
                    for (int m = 0; m < 4; ++m) acc[ai][bj][m][n] += bv; }
        f32x4 pre[4][2][2];
#pragma unroll
        for (int m = 0; m < 4; ++m) { const size_t off = (size_t)(u.pm * BM + wr * 64 + m * 16 + fr) * ldc + col0;
#pragma unroll
            for (int bj = 0; bj < 2; ++bj)
#pragma unroll
                for (int n = 0; n < 2; ++n) pre[m][bj][n] = *(const f32x4*)(base + off + bj * HALF + n * 16); }
        const bool bad = st.run(acc, u, wr, wc, fr, fq, lds, wid, lane) || poison != 0u;
        const float qnan = __builtin_nanf("");
#pragma unroll
        for (int ai = 0; ai < 2; ++ai)
#pragma unroll
            for (int m = 0; m < 4; ++m) { const int r = ai * HALF + wr * 64 + m * 16 + fr; const f32x2v sr = S[r]; const size_t off = (size_t)(u.pm * BM + r) * ldc + col0;
#pragma unroll
                for (int bj = 0; bj < 2; ++bj)
#pragma unroll
                    for (int n = 0; n < 2; ++n) { const f32x4 bs = ai == 0 ? pre[m][bj][n] : *(const f32x4*)(base + off + bj * HALF + n * 16); f32x4 o = bs + (acc[ai][bj][m][n] - sr.x) * sr.y;
                        if (bad) o = (f32x4){qnan, qnan, qnan, qnan}; *(f32x4*)(out + off + bj * HALF + n * 16) = o; }
                if (m & 1) asm volatile("" ::: "memory"); }
    }
};
struct EpiLnResLn {
    static constexpr bool PERM = false, AFTER_DRAIN = true;
    const float* base; float* out; bf16_t* xn; int ldc; const float* bias; PanelStats st1, st2; unsigned poison;
    __device__ __forceinline__ void fused(f32x4 (&acc)[2][2][4][2], const Unit& u, int wr, int wc, int fr, int fq, PG8_LAS unsigned char* lds, int wid, int lane) const {
        typedef float f32x2v __attribute__((ext_vector_type(2))); typedef unsigned u32x2v __attribute__((ext_vector_type(2)));
        const PG8_LAS f32x2v* S = (const PG8_LAS f32x2v*)(lds + 8192);
        const int col0 = u.pn * BM + wc * 32 + 4 * fq;
#pragma unroll
        for (int bj = 0; bj < 2; ++bj)
#pragma unroll
            for (int n = 0; n < 2; ++n) { const f32x4 bv = bias ? *(const f32x4*)(bias + col0 + bj * HALF + n * 16) : (f32x4){0.f, 0.f, 0.f, 0.f};
#pragma unroll
                for (int ai = 0; ai < 2; ++ai)
#pragma unroll
                    for (int m = 0; m < 4; ++m) acc[ai][bj][m][n] += bv; }
        bool bad = st1.run(acc, u, wr, wc, fr, fq, lds, wid, lane) || poison != 0u;
        const float qnan = __builtin_nanf("");
#pragma unroll
        for (int ai = 0; ai < 2; ++ai)
#pragma unroll
            for (int m = 0; m < 4; ++m) { const int r = ai * HALF + wr * 64 + m * 16 + fr; const f32x2v sr = S[r]; const size_t off = (size_t)(u.pm * BM + r) * ldc + col0;
#pragma unroll
                for (int bj = 0; bj < 2; ++bj)
#pragma unroll
                    for (int n = 0; n < 2; ++n) { const f32x4 bs = *(const f32x4*)(base + off + bj * HALF + n * 16); acc[ai][bj][m][n] = bs + (acc[ai][bj][m][n] - sr.x) * sr.y; }
                asm volatile("" : "+v"(acc[ai][0][m][0]), "+v"(acc[ai][0][m][1]), "+v"(acc[ai][1][m][0]), "+v"(acc[ai][1][m][1]));
                if (m & 1) asm volatile("" ::: "memory"); }
        const bool bad1 = bad;
        bad = st2.run(acc, u, wr, wc, fr, fq, lds, wid, lane) || bad;
#pragma unroll
        for (int ai = 0; ai < 2; ++ai)
#pragma unroll
            for (int m = 0; m < 4; ++m) { const int r = ai * HALF + wr * 64 + m * 16 + fr; const f32x2v sr = S[r]; const size_t off = (size_t)(u.pm * BM + r) * ldc + col0;
#pragma unroll
                for (int bj = 0; bj < 2; ++bj)
#pragma unroll
                    for (int n = 0; n < 2; ++n) { const f32x4 x1 = acc[ai][bj][m][n]; *(f32x4*)(out + off + bj * HALF + n * 16) = bad1 ? (f32x4){qnan, qnan, qnan, qnan} : x1;
                        const f32x4 o = (x1 - sr.x) * sr.y; u32x2v w; w.x = cvt_pk_bf16(o[0], o[1]); w.y = cvt_pk_bf16(o[2], o[3]);
                        if (bad) { w.x = 0x7fc07fc0u; w.y = 0x7fc07fc0u; } *(u32x2v*)(xn + off + bj * HALF + n * 16) = w; }
                asm volatile("" ::: "memory"); }
    }
};

template <class Epi, class Sched, bool ALIGN_EPI = false, bool SP2 = false>
__device__ __forceinline__ void gemm_phase(PG8_LAS unsigned char* lds, const Gemm g, const Sched& S, const Epi& E) {
    const int tid = threadIdx.x, wid = __builtin_amdgcn_readfirstlane(tid >> 6), lane = tid & 63, wr = wid >> 2, wc = wid & 3, fr = lane & 15, fq = lane >> 4;
    const int K = g.K, nt = K / BK;
    unsigned voffA[2], voffB[2];
#pragma unroll
    for (int i = 0; i < 2; ++i) { int R, C; stage_rc(tid * 16 + i * 8192, R, C); const int Rb = Epi::PERM ? ((R & ~31) + perm32(R & 31)) : R;
        voffA[i] = (unsigned)(R * K + C) * 2u; voffB[i] = (unsigned)(Rb * K + C) * 2u; }
    const size_t kstep = (size_t)(BK * 2);
    const size_t hstep = (size_t)HALF * K * 2;
    const size_t tstep = 2 * hstep;
    const unsigned ldsw = (unsigned)wid * 1024u;
    const int aoff = lds_byte(wr * 64 + fr, fq * 8), boff = lds_byte(wc * 32 + fr, fq * 8);
#define PG8_SA(b, h) (((b) * 2 + (h)) * HTB)
#define PG8_SB(b, h) ((4 + (b) * 2 + (h)) * HTB)
#define PG8_STAGE(bufoff, gbase, voff) do { _Pragma("unroll") for (int _i = 0; _i < 2; ++_i) \
        __builtin_amdgcn_global_load_lds((const unsigned*)((const char*)(gbase) + (voff)[_i]), (PG8_LAS unsigned*)(lds + (bufoff) + ldsw + _i * 8192), 16, 0, 0); } while (0)
#define PG8_LDA(dst, b, h) do { _Pragma("unroll") for (int m = 0; m < 4; ++m) _Pragma("unroll") for (int k = 0; k < 2; ++k) dst[m][k] = *(const PG8_LAS bf16x8*)(lds + PG8_SA(b, h) + aoff + m * 2048 + k * 1024); } while (0)
#define PG8_LDB(dst, b, h) do { _Pragma("unroll") for (int n = 0; n < 2; ++n) _Pragma("unroll") for (int k = 0; k < 2; ++k) dst[n][k] = *(const PG8_LAS bf16x8*)(lds + PG8_SB(b, h) + boff + n * 2048 + k * 1024); } while (0)
#define PG8_MMA(ai, bj, At, Bt) do { __builtin_amdgcn_s_setprio(1); _Pragma("unroll") for (int m = 0; m < 4; ++m) _Pragma("unroll") for (int n = 0; n < 2; ++n) _Pragma("unroll") for (int k = 0; k < 2; ++k) \
        acc[ai][bj][m][n] = __builtin_amdgcn_mfma_f32_16x16x32_bf16(Bt[n][k], At[m][k], acc[ai][bj][m][n], 0, 0, 0); __builtin_amdgcn_s_setprio(0); } while (0)
#define PG8_WAIT_V(n) asm volatile("s_waitcnt vmcnt(" #n ")" ::: "memory")
#define PG8_WAIT_L(n) asm volatile("s_waitcnt lgkmcnt(" #n ")" ::: "memory")
#define PG8_BAR __builtin_amdgcn_s_barrier()
#define PG8_SCHED __builtin_amdgcn_sched_barrier(0)
    Unit cur, nxt; int ui = 0;
    if (!S.next(0, cur)) return;
    f32x4 acc[2][2][4][2];
#pragma unroll
    for (int a = 0; a < 2; ++a)
#pragma unroll
        for (int b = 0; b < 2; ++b)
#pragma unroll
            for (int m = 0; m < 4; ++m)
#pragma unroll
                for (int n = 0; n < 2; ++n) acc[a][b][m][n] = (f32x4){0.f, 0.f, 0.f, 0.f};
    bf16x8 At[4][2], B0[2][2], B1[2][2];
    const char* cA = (const char*)g.A + (size_t)cur.pm * tstep; const char* cB = (const char*)g.Bt + (size_t)cur.pn * tstep;
    S.a_ready(cur);
    if constexpr (SP2) {
        PG8_STAGE(PG8_SB(0, 0), cB, voffB); PG8_STAGE(PG8_SB(0, 1), cB + hstep, voffB); PG8_STAGE(PG8_SA(0, 0), cA, voffA); PG8_STAGE(PG8_SA(0, 1), cA + hstep, voffA);
        if (wr == 1) PG8_BAR;
        PG8_WAIT_V(2); PG8_BAR;
        PG8_STAGE(PG8_SB(1, 0), cB + kstep, voffB); PG8_STAGE(PG8_SA(1, 0), cA + kstep, voffA); PG8_STAGE(PG8_SB(1, 1), cB + hstep + kstep, voffB);
        PG8_WAIT_V(6); PG8_BAR;
    } else {
        PG8_STAGE(PG8_SB(0, 0), cB, voffB); PG8_STAGE(PG8_SA(0, 0), cA, voffA); PG8_STAGE(PG8_SB(0, 1), cB + hstep, voffB); PG8_STAGE(PG8_SA(0, 1), cA + hstep, voffA);
        if (wr == 1) PG8_BAR;
        PG8_WAIT_V(4); PG8_BAR;
        PG8_STAGE(PG8_SB(1, 0), cB + kstep, voffB); PG8_STAGE(PG8_SA(1, 0), cA + kstep, voffA); PG8_STAGE(PG8_SB(1, 1), cB + hstep + kstep, voffB);
        PG8_WAIT_V(6); PG8_BAR;
    }
    for (;;) {
        const bool has_next = S.next(ui + 1, nxt);
        const char* nA = has_next ? (const char*)g.A + (size_t)nxt.pm * tstep : cA; const char* nB = has_next ? (const char*)g.Bt + (size_t)nxt.pn * tstep : cB;
        for (int t = 0; t < nt; t += 2) {
            const bool last = (t == nt - 2);
            const char* a1 = cA + (size_t)(t + 1) * kstep;
            const char* a2 = last ? nA : cA + (size_t)(t + 2) * kstep; const char* b2 = last ? nB : cB + (size_t)(t + 2) * kstep;
            const char* a3 = a2 + kstep; const char* b3 = b2 + kstep;
            if (last && has_next) S.a_ready(nxt);
            if constexpr (SP2) {
            PG8_LDB(B0, 0, 0); PG8_LDB(B1, 0, 1); PG8_SCHED; PG8_LDA(At, 0, 0); PG8_STAGE(PG8_SA(1, 1), a1 + hstep, voffA);
            PG8_WAIT_V(8); PG8_WAIT_L(0); PG8_BAR; PG8_MMA(0, 0, At, B0); PG8_MMA(0, 1, At, B1); PG8_BAR; PG8_SCHED;
            PG8_LDA(At, 0, 1); PG8_STAGE(PG8_SB(0, 0), b2, voffB); PG8_STAGE(PG8_SB(0, 1), b2 + hstep, voffB); PG8_STAGE(PG8_SA(0, 0), a2, voffA);
            PG8_WAIT_V(8); PG8_WAIT_L(0); PG8_BAR; PG8_MMA(1, 0, At, B0); PG8_MMA(1, 1, At, B1); PG8_BAR; PG8_SCHED;
            PG8_LDB(B0, 1, 0); PG8_LDB(B1, 1, 1); PG8_SCHED; PG8_LDA(At, 1, 0); PG8_STAGE(PG8_SA(0, 1), a2 + hstep, voffA);
            PG8_WAIT_V(8); PG8_WAIT_L(0); PG8_BAR; PG8_MMA(0, 0, At, B0); PG8_MMA(0, 1, At, B1); PG8_BAR; PG8_SCHED;
            PG8_LDA(At, 1, 1); PG8_STAGE(PG8_SB(1, 0), b3, voffB); PG8_STAGE(PG8_SB(1, 1), b3 + hstep, voffB); PG8_STAGE(PG8_SA(1, 0), a3, voffA);
            PG8_WAIT_V(8); PG8_WAIT_L(0); PG8_BAR; PG8_MMA(1, 0, At, B0); PG8_MMA(1, 1, At, B1); PG8_BAR; PG8_SCHED;
            } else {
            PG8_LDB(B0, 0, 0); PG8_SCHED; PG8_LDA(At, 0, 0); PG8_STAGE(PG8_SA(1, 1), a1 + hstep, voffA);
            PG8_WAIT_L(8); PG8_BAR; PG8_WAIT_L(0); PG8_MMA(0, 0, At, B0); PG8_BAR; PG8_SCHED;
            PG8_LDB(B1, 0, 1); PG8_STAGE(PG8_SB(0, 0), b2, voffB);
            PG8_BAR; PG8_WAIT_L(0); PG8_MMA(0, 1, At, B1); PG8_BAR;
            PG8_LDA(At, 0, 1); PG8_STAGE(PG8_SA(0, 0), a2, voffA);
            PG8_BAR; PG8_WAIT_L(0); PG8_MMA(1, 0, At, B0); PG8_BAR; PG8_SCHED;
            PG8_STAGE(PG8_SB(0, 1), b2 + hstep, voffB);
            PG8_WAIT_V(6); PG8_BAR; PG8_MMA(1, 1, At, B1); PG8_BAR;
            PG8_LDB(B0, 1, 0); PG8_SCHED; PG8_LDA(At, 1, 0); PG8_STAGE(PG8_SA(0, 1), a2 + hstep, voffA);
            PG8_WAIT_L(8); PG8_BAR; PG8_WAIT_L(0); PG8_MMA(0, 0, At, B0); PG8_BAR; PG8_SCHED;
            PG8_LDB(B1, 1, 1); PG8_STAGE(PG8_SB(1, 0), b3, voffB);
            PG8_BAR; PG8_WAIT_L(0); PG8_MMA(0, 1, At, B1); PG8_BAR;
            PG8_LDA(At, 1, 1); PG8_STAGE(PG8_SA(1, 0), a3, voffA);
            PG8_BAR; PG8_WAIT_L(0); PG8_MMA(1, 0, At, B0); PG8_BAR; PG8_SCHED;
            PG8_STAGE(PG8_SB(1, 1), b3 + hstep, voffB);
            PG8_WAIT_V(6); PG8_BAR; PG8_MMA(1, 1, At, B1); PG8_BAR;
            }
        }
        if constexpr (ALIGN_EPI) { if (wr == 0) PG8_BAR; }
        if constexpr (!Epi::AFTER_DRAIN) { E(acc, cur, wr, wc, fr, fq); S.done(cur); }
        if (!has_next) break;
#pragma unroll
        for (int a = 0; a < 2; ++a)
#pragma unroll
            for (int b = 0; b < 2; ++b)
#pragma unroll
                for (int m = 0; m < 4; ++m)
#pragma unroll
                    for (int n = 0; n < 2; ++n) acc[a][b][m][n] = (f32x4){0.f, 0.f, 0.f, 0.f};
        cur = nxt; cA = nA; cB = nB; ++ui;
        if constexpr (ALIGN_EPI) { if (wr == 1) PG8_BAR; }
    }
    PG8_WAIT_V(0);
    if constexpr (!ALIGN_EPI) { if (wr == 0) PG8_BAR; }
    PG8_BAR;
    if constexpr (Epi::AFTER_DRAIN) { E.fused(acc, cur, wr, wc, fr, fq, lds, wid, lane); S.done(cur); }
#undef PG8_SA
#undef PG8_SB
#undef PG8_STAGE
#undef PG8_LDA
#undef PG8_LDB
#undef PG8_MMA
#undef PG8_WAIT_V
#undef PG8_WAIT_L
#undef PG8_BAR
#undef PG8_SCHED
}
}
typedef float f32x2_t __attribute__((ext_vector_type(2))); typedef __bf16 bf16x2_t __attribute__((ext_vector_type(2)));
__device__ __forceinline__ unsigned cvtpk(float lo, float hi) { const f32x2_t v = {lo, hi}; const bf16x2_t b = __builtin_convertvector(v, bf16x2_t); return __builtin_bit_cast(unsigned, b); }
namespace pg8 {
struct EpiF32 {
    static constexpr bool PERM = false, AFTER_DRAIN = false;
    float* C; int ldc; int pad;
    __device__ __forceinline__ void operator()(const f32x4 (&acc)[2][2][4][2], const Unit& u, int wr, int wc, int fr, int fq) const {
        const int row0 = u.pm * BM + wr * 64 + fr, col0 = u.pn * BM + wc * 32 + 4 * fq;
#pragma unroll
        for (int ai = 0; ai < 2; ++ai)
#pragma unroll
            for (int m = 0; m < 4; ++m) { float* rowp = C + (size_t)(row0 + ai * HALF + m * 16) * ldc + col0;
#pragma unroll
                for (int bj = 0; bj < 2; ++bj)
#pragma unroll
                    for (int n = 0; n < 2; ++n) *(f32x4*)(rowp + bj * HALF + n * 16) = acc[ai][bj][m][n]; }
    }
};
struct EpiStoreBf16P {
    static constexpr bool PERM = true, AFTER_DRAIN = false;
    bf16_t* O; int ldc; int npn;
    __device__ __forceinline__ void operator()(const f32x4 (&acc)[2][2][4][2], const Unit& u, int wr, int wc, int fr, int fq) const {
        const int row0 = u.pm * BM + wr * 64 + fr, col0 = (u.pn % npn) * BM + wc * 32 + 8 * fq;
#pragma unroll
        for (int ai = 0; ai < 2; ++ai)
#pragma unroll
            for (int m = 0; m < 4; ++m) { bf16_t* rowp = O + (size_t)(row0 + ai * HALF + m * 16) * ldc + col0;
#pragma unroll
                for (int bj = 0; bj < 2; ++bj) { const f32x4 v0 = acc[ai][bj][m][0], v1 = acc[ai][bj][m][1];
                    u32x4 w; w.x = cvtpk(v0[0], v0[1]); w.y = cvtpk(v0[2], v0[3]); w.z = cvtpk(v1[0], v1[1]); w.w = cvtpk(v1[2], v1[3]);
                    *(u32x4*)(rowp + bj * HALF) = w; } }
    }
};
__device__ __forceinline__ float silu_mul(float g, float u) { return g * u * __builtin_amdgcn_rcpf(1.0f + __builtin_amdgcn_exp2f(-1.4426950408889634f * g)); }
struct EpiSwiGLU {
    static constexpr bool PERM = true, AFTER_DRAIN = false;
    bf16_t* O; int ldc; int npn;
    __device__ __forceinline__ void operator()(const f32x4 (&acc)[2][2][4][2], const Unit& u, int wr, int wc, int fr, int fq) const {
        const int row0 = u.pm * BM + wr * 64 + fr, col0 = (u.pn % npn) * HALF + wc * 32 + 8 * fq;
#pragma unroll
        for (int ai = 0; ai < 2; ++ai)
#pragma unroll
            for (int m = 0; m < 4; ++m) { bf16_t* rowp = O + (size_t)(row0 + ai * HALF + m * 16) * ldc + col0;
                const f32x4 g0 = acc[ai][0][m][0], g1 = acc[ai][0][m][1], u0 = acc[ai][1][m][0], u1 = acc[ai][1][m][1];
                u32x4 w; w.x = cvtpk(silu_mul(g0[0], u0[0]), silu_mul(g0[1], u0[1])); w.y = cvtpk(silu_mul(g0[2], u0[2]), silu_mul(g0[3], u0[3]));
                w.z = cvtpk(silu_mul(g1[0], u1[0]), silu_mul(g1[1], u1[1])); w.w = cvtpk(silu_mul(g1[2], u1[2]), silu_mul(g1[3], u1[3]));
                *(u32x4*)rowp = w; }
    }
};
struct GroupedOrder {
    StaticOrder so; int npn; int ts[9];
    __device__ __forceinline__ bool next(int i, Unit& u) const {
        if (!so.next(i, u)) return false;
        int e = 0;
#pragma unroll
        for (int j = 1; j < 8; ++j) e += (u.pm >= ts[j]) ? 1 : 0;
        u.pn += e * npn; return true;
    }
    __device__ __forceinline__ void a_ready(const Unit&) const {}
    __device__ __forceinline__ void done(const Unit&) const {}
};
}
#ifndef PG8_SP2
#define PG8_SP2 true
#endif
#ifndef PG8_ALIGN
#define PG8_ALIGN true
#endif

constexpr int NWAVES = 8;
constexpr int D = 1024, BATCH = 4, SEQ = 4096, M = BATCH * SEQ;
constexpr int DIN = 2560, DFF = 2816, NEXP = 8;
constexpr int C_POOL = 0, C_QC = 256, C_KC = 640, C_VC = 1024, C_QS = 1408, C_KS = 1792, C_VS = 2176;
constexpr float ALPHA = 1.4142135623730951f, LN_EPS = 1e-5f, RMS_EPS = 1e-6f, LOG2E = 1.4426950408889634f;
constexpr int MAXSLOT = 34816, MAXTILES = MAXSLOT / 256;

constexpr size_t MiB = 1u << 20;
constexpr size_t WS_CTL = 0, CTL_ZERO_BYTES = 64 * 1024;
constexpr size_t WS_TOKE = 64 * 1024, WS_TOKW = 192 * 1024, WS_TOKS = 320 * 1024, WS_CNT = 448 * 1024, WS_GATES = 512 * 1024;
constexpr size_t WS_MWGU = 1 * MiB, WS_MWD = 89 * MiB;
constexpr size_t WS_WIN = 133 * MiB, WS_WOUT = 143 * MiB, WS_WGU = 147 * MiB, WS_WD = 158 * MiB;
constexpr size_t WS_HB = 164 * MiB, WS_YB = 252 * MiB, WS_MF = 284 * MiB, WS_XB = 348 * MiB;
constexpr size_t WS_XPERM = 133 * MiB, WS_HPERM = 201 * MiB, WS_YPERM = 1 * MiB, WS_END = 388 * MiB;
constexpr int CW_TMO = 0, CW_CODE = 1, CW_BAR = 4096;

constexpr int RING_OFF = 0, RING_BYTES = 131072;
constexpr int LDSCTL_OFF = RING_BYTES, MISC_OFF = LDSCTL_OFF + 320;
constexpr int LDS_BYTES = 147456;

#define GAS __attribute__((address_space(1)))
#define LAS __attribute__((address_space(3)))
typedef unsigned short bf16;
typedef unsigned v4u __attribute__((ext_vector_type(4)));
typedef unsigned v2u __attribute__((ext_vector_type(2)));
typedef float f32x4 __attribute__((ext_vector_type(4)));
typedef float f32x16 __attribute__((ext_vector_type(16)));
typedef short bf16x8 __attribute__((ext_vector_type(8)));
typedef GAS unsigned gu32;
#define RLX_AGENT __ATOMIC_RELAXED, __HIP_MEMORY_SCOPE_AGENT
#define LDS_WAIT() asm volatile("s_waitcnt lgkmcnt(0)" ::: "memory")
#define VM_WAIT() asm volatile("s_waitcnt vmcnt(0)" ::: "memory")
__device__ __forceinline__ unsigned f2bf(float f) { unsigned u = __builtin_bit_cast(unsigned, f); return (u + 0x7fffu + ((u >> 16) & 1u)) >> 16; }
__device__ __forceinline__ unsigned pk2(float lo, float hi) { return cvtpk(lo, hi); }
__device__ __forceinline__ float bf2f(unsigned short h) { return __uint_as_float(((unsigned)h) << 16); }
__device__ __forceinline__ float bflo(unsigned w) { return __uint_as_float(w << 16); }
__device__ __forceinline__ float bfhi(unsigned w) { return __uint_as_float(w & 0xffff0000u); }
__device__ __forceinline__ float wave_sum(float v) {
#pragma unroll
    for (int o = 1; o < 64; o <<= 1) v += __shfl_xor(v, o);
    return v;
}
#define XB_TMO      128
#define XB_XCNT(j)  (256  + 64 * (j))
#define XB_XSUB(j)  (1280 + 64 * (j))
#define XB_XGEN(j)  (2304 + 64 * (j))
#define XB_TOP      3328
#define XB_TOPGEN   3392
#define XCD_BAR_WORDS 3456
#define XB_SPIN_CAP (1u << 18)

__device__ __forceinline__ unsigned xb_ld(unsigned* p)              { return __hip_atomic_load(p, __ATOMIC_RELAXED, __HIP_MEMORY_SCOPE_AGENT); }
__device__ __forceinline__ unsigned xb_add(unsigned* p, unsigned v) { return __hip_atomic_fetch_add(p, v, __ATOMIC_RELAXED, __HIP_MEMORY_SCOPE_AGENT); }
__device__ __forceinline__ unsigned xb_xcc_id() { return (unsigned)__builtin_amdgcn_s_getreg((3 << 11) | 20) & 0xFu; }
#define XB_SPIN(cond, bar) do { unsigned _sp = 0; while (cond) { __builtin_amdgcn_s_sleep(1); \
    if ((++_sp & 255u) == 0u) { if (xb_ld(&(bar)[XB_TMO])) break; if (_sp > XB_SPIN_CAP) { atomicAdd(&(bar)[XB_TMO], 1u); break; } } } } while (0)

struct XcdBarrier {
    unsigned* bar; unsigned x;
    volatile LAS unsigned* st;
};

__device__ __forceinline__ XcdBarrier xcd_barrier_post(unsigned* bar, volatile LAS unsigned* st) {
    XcdBarrier b; b.bar = bar; b.x = xb_xcc_id(); b.st = st;
    if (threadIdx.x == 0) (void)xb_add(&bar[XB_XCNT(b.x)], 1u);
    return b;
}
__device__ __forceinline__ void xcd_barrier_complete(unsigned* bar, unsigned x, unsigned& nloc, unsigned& nx) {
    const unsigned G = gridDim.x * gridDim.y * gridDim.z;
    unsigned sum, cnt, mine, sp = 0u;
    for (;;) {
        sum = 0u; cnt = 0u; mine = 0u;
#pragma unroll
        for (unsigned j = 0; j < 16; ++j) { const unsigned c = xb_ld(&bar[XB_XCNT(j)]); sum += c; cnt += (c > 0u) ? 1u : 0u; mine = (j == x) ? c : mine; }
        if (sum == G) break;
        __builtin_amdgcn_s_sleep(1);
        if ((++sp & 255u) == 0u) { if (xb_ld(&bar[XB_TMO])) break; if (sp > XB_SPIN_CAP) { atomicAdd(&bar[XB_TMO], 1u); break; } }
    }
    nloc = mine > 0u ? mine : 1u; nx = cnt > 0u ? cnt : 1u;
}

__device__ __forceinline__ void xcd_barrier(const XcdBarrier& b) {
    asm volatile("s_waitcnt vmcnt(0)" ::: "memory");
    __syncthreads();
    if (threadIdx.x == 0) {
        unsigned* bar = b.bar;
        __builtin_amdgcn_s_waitcnt(0);
        unsigned nloc = b.st[0], nx = b.st[1];
        if (nloc == 0u) { xcd_barrier_complete(bar, b.x, nloc, nx); b.st[0] = nloc; b.st[1] = nx; }
        const unsigned old = xb_add(&bar[XB_XSUB(b.x)], 1u);
        const unsigned gen = old / nloc;
        if (old + 1u == (gen + 1u) * nloc) {
            __builtin_amdgcn_fence(__ATOMIC_RELEASE, "agent");
            asm volatile("s_waitcnt vmcnt(0)" ::: "memory");
            const unsigned og = xb_add(&bar[XB_TOP], 1u);
            const unsigned tg = og / nx;
            if (og + 1u == (tg + 1u) * nx) xb_add(&bar[XB_TOPGEN], 1u);
            else XB_SPIN(xb_ld(&bar[XB_TOPGEN]) == tg, bar);
            __builtin_amdgcn_fence(__ATOMIC_ACQUIRE, "agent");
            xb_add(&bar[XB_XGEN(b.x)], 1u);
            asm volatile("s_waitcnt vmcnt(0)" ::: "memory");
        } else {
            XB_SPIN(xb_ld(&bar[XB_XGEN(b.x)]) == gen, bar);
            __builtin_amdgcn_fence(__ATOMIC_ACQUIRE, "agent");
            asm volatile("s_waitcnt vmcnt(0)" ::: "memory");
        }
    }
    __syncthreads();
}
#ifndef MIXER_INLINE
#define MIXER_INLINE __forceinline__
#endif
constexpr int MX_SSQ = 0, MX_BIAS = 1024, MX_U = 8192, MX_P = 8192 + 40960, MX_V = 8192, MX_VW = 9216, MX_VP = 144;
typedef short v4i16_t __attribute__((ext_vector_type(4)));
#define MFMA32(a, b, c) __builtin_amdgcn_mfma_f32_32x32x16_bf16((a), (b), (c), 0, 0, 0)
__device__ __forceinline__ bf16x8 vtr2(const LAS unsigned char* p0, const LAS unsigned char* p1) {
    const v4i16_t a = __builtin_amdgcn_ds_read_tr16_b64_v4i16((LAS v4i16_t*)p0), b = __builtin_amdgcn_ds_read_tr16_b64_v4i16((LAS v4i16_t*)p1);
    return (bf16x8){a[0], a[1], a[2], a[3], b[0], b[1], b[2], b[3]};
}
__device__ __forceinline__ bf16x8 pack8(const f32x16& p, int base) {
    v4u w; w.x = cvtpk(p[base], p[base + 1]); w.y = cvtpk(p[base + 2], p[base + 3]); w.z = cvtpk(p[base + 4], p[base + 5]); w.w = cvtpk(p[base + 6], p[base + 7]);
    return __builtin_bit_cast(bf16x8, w);
}
__device__ __forceinline__ float xhalf_sum(float x) { const auto rr = __builtin_amdgcn_permlane32_swap(__float_as_uint(x), __float_as_uint(x), false, false); return __uint_as_float(rr[0]) + __uint_as_float(rr[1]); }
__device__ __forceinline__ float xhalf_max(float x) { const auto rr = __builtin_amdgcn_permlane32_swap(__float_as_uint(x), __float_as_uint(x), false, false); return fmaxf(__uint_as_float(rr[0]), __uint_as_float(rr[1])); }
__device__ __forceinline__ void load_v8(v4u (&v)[8], const GAS bf16* __restrict__ vsrc  , int lane) {
#pragma unroll
    for (int i = 0; i < 8; ++i) { const int c8 = lane + 64 * i, key = c8 >> 3, part = c8 & 7; v[i] = *(const GAS v4u*)(vsrc + (size_t)key * DIN + part * 8); }
}
__device__ __forceinline__ void write_v8(const v4u (&v)[8], LAS unsigned char* vt, int lane) {
#pragma unroll
    for (int i = 0; i < 8; ++i) { const int c8 = lane + 64 * i, key = c8 >> 3, part = c8 & 7; *(LAS v4u*)(vt + key * MX_VP + part * 16) = v[i]; }
}
__device__ __forceinline__ void load_k8(bf16x8 (&k)[8], const GAS bf16* __restrict__ ksrc  , int r32, int hi) {
#pragma unroll
    for (int i = 0; i < 8; ++i) k[i] = *(const GAS bf16x8*)(ksrc + (size_t)(32 * (i >> 2) + r32) * DIN + 16 * (i & 3) + 8 * hi);
}
__device__ __forceinline__ void pv_block(f32x16& o0, f32x16& o1, const f32x16& p, const LAS unsigned char* vt, int kb, int lane) {
    const int hi = lane >> 5, blk = (lane >> 4) & 1, qq = (lane & 15) >> 2, pp = lane & 3;
#pragma unroll
    for (int sh = 0; sh < 2; ++sh) {
        const bf16x8 pf = pack8(p, 8 * sh);
        const LAS unsigned char* base = vt + (32 * kb + 16 * sh + 4 * hi + qq) * MX_VP + 32 * blk + 8 * pp;
        const bf16x8 v0 = vtr2(base, base + 8 * MX_VP), v1 = vtr2(base + 64, base + 64 + 8 * MX_VP);
        o0 = MFMA32(v0, pf, o0); o1 = MFMA32(v1, pf, o1);
    }
}
__device__ __forceinline__ void store_ot(GAS float* __restrict__ yrow  , const f32x16& o0, const f32x16& o1, float scale, LAS float* ssq_slot, int lane) {
    const int hi = lane >> 5; float q = 0.f;
#pragma unroll
    for (int gq = 0; gq < 4; ++gq) {
        f32x4 a, b;
#pragma unroll
        for (int i = 0; i < 4; ++i) { a[i] = o0[4 * gq + i] * scale; b[i] = o1[4 * gq + i] * scale; q += a[i] * a[i] + b[i] * b[i]; }
        *(GAS f32x4*)(yrow + 8 * gq + 4 * hi) = a; *(GAS f32x4*)(yrow + 32 + 8 * gq + 4 * hi) = b;
    }
    q = xhalf_sum(q);
    if (hi == 0) __hip_atomic_fetch_add(ssq_slot, q, __ATOMIC_RELAXED, __HIP_MEMORY_SCOPE_WORKGROUP);
}

__device__ __forceinline__ void chunk_item(const GAS bf16* __restrict__ H, GAS float* __restrict__ Yraw, LAS unsigned char* lds, int b, int chunk, int h, int qh, int wave, int lane) {
    const int r32 = lane & 31, hi = lane >> 5;
    const size_t row0 = (size_t)b * SEQ + chunk * 64;
    const LAS float* biasl = (const LAS float*)(lds + MX_BIAS) + h * 260;
    LAS unsigned char* vt = lds + MX_V + wave * MX_VW;
    bf16x8 qf[4];
#pragma unroll
    for (int s = 0; s < 4; ++s) qf[s] = *(const GAS bf16x8*)(H + (row0 + 32 * qh + r32) * DIN + C_QC + h * 64 + 16 * s + 8 * hi);
    f32x16 o0 = {}, o1 = {};
    float m = -1e30f, l = 0.f;
    const float c1 = 0.125f * LOG2E;
    const int kt_lo = chunk >= 8 ? 0 : 8 - chunk;
    const GAS bf16* hk = H + ((size_t)b * SEQ + (size_t)(chunk - 8 + kt_lo) * 64) * DIN + h * 64;
    v4u vn[8]; bf16x8 kn[8];
    load_v8(vn, hk + C_VC, lane); load_k8(kn, hk + C_KC, r32, hi);
    for (int kt = kt_lo; kt <= 8; ++kt) {
        asm volatile("" ::: "memory"); write_v8(vn, vt, lane); asm volatile("" ::: "memory");
        f32x16 s0 = {}, s1 = {};
#pragma unroll
        for (int s = 0; s < 4; ++s) { s0 = MFMA32(kn[s], qf[s], s0); s1 = MFMA32(kn[4 + s], qf[s], s1); }
        hk += (size_t)64 * DIN;
        if (kt < 8) { load_v8(vn, hk + C_VC, lane); load_k8(kn, hk + C_KC, r32, hi); }
        if (kt <= 5) {
            const float bc = biasl[256];
#pragma unroll
            for (int r = 0; r < 16; ++r) { s0[r] = s0[r] * c1 + bc; s1[r] = s1[r] * c1 + bc; }
        } else {
            const int base = 64 * (8 - kt) + 32 * qh + r32 - 4 * hi + 128;
#pragma unroll
            for (int r = 0; r < 16; ++r) { const int ro = (r & 3) + 8 * (r >> 2);
                int i0 = base - ro, i1 = base - 32 - ro; i0 = i0 < 0 ? 0 : (i0 > 256 ? 256 : i0); i1 = i1 < 0 ? 0 : (i1 > 256 ? 256 : i1);
                s0[r] = s0[r] * c1 + biasl[i0]; s1[r] = s1[r] * c1 + biasl[i1]; }
        }
        float ml = fmaxf(s0[0], s1[0]);
#pragma unroll
        for (int r = 1; r < 16; ++r) ml = fmaxf(ml, fmaxf(s0[r], s1[r]));
        ml = xhalf_max(ml);
        const float mn = fmaxf(m, ml), al = __builtin_amdgcn_exp2f(m - mn); m = mn;
        float ps = 0.f;
#pragma unroll
        for (int r = 0; r < 16; ++r) { s0[r] = __builtin_amdgcn_exp2f(s0[r] - mn); s1[r] = __builtin_amdgcn_exp2f(s1[r] - mn); ps += s0[r] + s1[r]; }
        l = l * al + ps;
#pragma unroll
        for (int r = 0; r < 16; ++r) { o0[r] *= al; o1[r] *= al; }
        pv_block(o0, o1, s0, vt, 0, lane);
        pv_block(o0, o1, s1, vt, 1, lane);
    }
    l = xhalf_sum(l);
    store_ot(Yraw + (row0 + 32 * qh + r32) * D + 256 + h * 64, o0, o1, 1.0f / l, (LAS float*)(lds + MX_SSQ) + (32 * qh + r32) * 4 + 1, lane);
}

#define SB_BLOCK(KB, sa) do { \
    float a[16]; \
    _Pragma("unroll") for (int r = 0; r < 16; ++r) { \
        const float z2 = sa[r] * c1; \
        const bool valid = !diag || (32 * (KB) + (r & 3) + 8 * (r >> 2) + 4 * hi) < qpos; \
        const float sp = fmaxf(z2, 0.f) + __builtin_amdgcn_logf(1.0f + __builtin_amdgcn_exp2f(-fabsf(z2))); \
        a[r] = valid ? -sp : 0.f; \
        sa[r] = valid ? z2 : -1e30f; } \
    const float G0 = (a[0] + a[1]) + (a[2] + a[3]), G1 = (a[4] + a[5]) + (a[6] + a[7]), G2 = (a[8] + a[9]) + (a[10] + a[11]), G3 = (a[12] + a[13]) + (a[14] + a[15]); \
    const auto R0 = __builtin_amdgcn_permlane32_swap(__float_as_uint(G0), __float_as_uint(G0), false, false), R1 = __builtin_amdgcn_permlane32_swap(__float_as_uint(G1), __float_as_uint(G1), false, false); \
    const auto R2 = __builtin_amdgcn_permlane32_swap(__float_as_uint(G2), __float_as_uint(G2), false, false), R3 = __builtin_amdgcn_permlane32_swap(__float_as_uint(G3), __float_as_uint(G3), false, false); \
      \
    const float H0 = __uint_as_float(R0[1]), H1 = __uint_as_float(R1[1]), H2 = __uint_as_float(R2[1]), H3 = __uint_as_float(R3[1]); \
    const float T0 = __uint_as_float(R0[0]) + H0, T1 = __uint_as_float(R1[0]) + H1, T2 = __uint_as_float(R2[0]) + H2, T3 = __uint_as_float(R3[0]) + H3; \
    const float ab2 = T3, ab1 = ab2 + T2, ab0 = ab1 + T1, tot = ab0 + T0; \
    float off[4]; off[3] = carry + (hi == 0 ? H3 : 0.f); off[2] = carry + ab2 + (hi == 0 ? H2 : 0.f); off[1] = carry + ab1 + (hi == 0 ? H1 : 0.f); off[0] = carry + ab0 + (hi == 0 ? H0 : 0.f); \
    _Pragma("unroll") for (int g = 0; g < 4; ++g) { \
        const float s3 = off[g], s2 = s3 + a[4 * g + 3], s1_ = s2 + a[4 * g + 2], s0_ = s1_ + a[4 * g + 1]; \
        sa[4 * g + 3] = __builtin_amdgcn_exp2f(sa[4 * g + 3] + a[4 * g + 3] + s3); sa[4 * g + 2] = __builtin_amdgcn_exp2f(sa[4 * g + 2] + a[4 * g + 2] + s2); \
        sa[4 * g + 1] = __builtin_amdgcn_exp2f(sa[4 * g + 1] + a[4 * g + 1] + s1_); sa[4 * g] = __builtin_amdgcn_exp2f(sa[4 * g] + a[4 * g] + s0_); } \
    carry += tot; \
    pv_block(o0, o1, sa, vt, (KB), lane); } while (0)

__device__ __forceinline__ void sb_item(const GAS bf16* __restrict__ H, GAS float* __restrict__ Yraw, LAS unsigned char* lds, int b, int chunk, int h, int qh, int wave, int lane) {
    const int r32 = lane & 31, hi = lane >> 5;
    const size_t row0 = (size_t)b * SEQ + chunk * 64;
    LAS unsigned char* vt = lds + MX_V + wave * MX_VW;
    bf16x8 qf[4];
#pragma unroll
    for (int s = 0; s < 4; ++s) qf[s] = *(const GAS bf16x8*)(H + (row0 + 32 * qh + r32) * DIN + C_QS + h * 64 + 16 * s + 8 * hi);
    f32x16 o0 = {}, o1 = {};
    float carry = 0.f;
    const float c1 = 0.125f * LOG2E;
    const int qpos = 32 * qh + r32;
    const GAS bf16* hk = H + row0 * DIN + h * 64;
    v4u vn[8]; bf16x8 kn[8];
    load_v8(vn, hk + C_VS, lane); load_k8(kn, hk + C_KS, r32, hi);
    for (int kt = chunk; kt >= 0; --kt) {
        const bool diag = kt == chunk;
        asm volatile("" ::: "memory"); write_v8(vn, vt, lane); asm volatile("" ::: "memory");
        f32x16 s0 = {}, s1 = {};
#pragma unroll
        for (int s = 0; s < 4; ++s) { s0 = MFMA32(kn[s], qf[s], s0); s1 = MFMA32(kn[4 + s], qf[s], s1); }
        hk -= (size_t)64 * DIN;
        if (kt > 0) { load_v8(vn, hk + C_VS, lane); load_k8(kn, hk + C_KS, r32, hi); }
        if (!(diag && qh == 0)) SB_BLOCK(1, s1);
        SB_BLOCK(0, s0);
        if (__all(carry < -151.0f)) break;
    }
    store_ot(Yraw + (row0 + 32 * qh + r32) * D + 640 + h * 64, o0, o1, 1.0f, (LAS float*)(lds + MX_SSQ) + (32 * qh + r32) * 4 + 2, lane);
}

__device__ MIXER_INLINE void mixer_unit(LAS unsigned char* lds, const GAS bf16* __restrict__ H, GAS float* __restrict__ Yraw, GAS bf16* __restrict__ Yb,
                                           const GAS float* __restrict__ pool_w, const GAS float* __restrict__ pool_scale, const GAS float* __restrict__ rel_bias, const GAS float* __restrict__ g_mix,
                                           int b, int chunk, int tid, int wave, int lane) {
    const int t0 = chunk * 64, r32 = lane & 31, hi = lane >> 5;
    const size_t row0 = (size_t)b * SEQ + t0;
    LAS float* ssq = (LAS float*)(lds + MX_SSQ);
    if (tid < 256) ssq[tid] = 0.f;
    for (int i = tid; i < 6 * 257; i += NWAVES * 64) { const int hh = i / 257, j = i - hh * 257; ((LAS float*)(lds + MX_BIAS))[hh * 260 + j] = rel_bias[i] * LOG2E; }
    for (int i = tid; i < 80 * 32; i += NWAVES * 64) { const int r = i >> 5, ch = i & 31; v4u v = (v4u){0u, 0u, 0u, 0u};
        if (t0 - 16 + r >= 0) v = *(const GAS v4u*)(H + (row0 - 16 + r) * DIN + ch * 8);
        *(LAS v4u*)(lds + MX_U + r * 512 + ch * 16) = v; }
    __syncthreads();
    { const int c = tid & 255, th = tid >> 8, w = 2 << (c >> 6), tt0 = 32 * th;
      const LAS bf16* ucol = (const LAS bf16*)(lds + MX_U) + c;
      float s = 0.f;
      for (int k = 1; k < w; ++k) s += bf2f(ucol[(tt0 + 16 - k) * 256]);
      for (int tt = tt0; tt < tt0 + 32; ++tt) {
          const float ut = bf2f(ucol[(tt + 16) * 256]); s += ut;
          const int t = t0 + tt; const float cnt = (float)(t + 1 < w ? t + 1 : w);
          *((LAS bf16*)(lds + MX_P + tt * 528) + c) = (bf16)f2bf(s / cnt - ut);
          s -= bf2f(ucol[(tt + 17 - w) * 256]); } }
    __syncthreads();
    { const int g = wave & 3, th = wave >> 2;
      f32x16 acc0 = {}, acc1 = {};
#pragma unroll
      for (int s = 0; s < 4; ++s) {
          const bf16x8 bfr = *(const LAS bf16x8*)(lds + MX_P + (32 * th + r32) * 528 + (g * 64 + 16 * s + 8 * hi) * 2);
          v4u a0, a1; const GAS float* pw = pool_w + (size_t)(g * 64 + 16 * s + 8 * hi) * 64 + r32;
          a0.x = cvtpk(pw[0], pw[64]); a0.y = cvtpk(pw[128], pw[192]); a0.z = cvtpk(pw[256], pw[320]); a0.w = cvtpk(pw[384], pw[448]);
          a1.x = cvtpk(pw[32], pw[96]); a1.y = cvtpk(pw[160], pw[224]); a1.z = cvtpk(pw[288], pw[352]); a1.w = cvtpk(pw[416], pw[480]);
          acc0 = MFMA32(__builtin_bit_cast(bf16x8, a0), bfr, acc0); acc1 = MFMA32(__builtin_bit_cast(bf16x8, a1), bfr, acc1);
      }
#pragma unroll
      for (int r = 0; r < 16; ++r) { const int d = (r & 3) + 8 * (r >> 2) + 4 * hi; acc0[r] *= pool_scale[g * 64 + d]; acc1[r] *= pool_scale[g * 64 + 32 + d]; }
      store_ot(Yraw + (row0 + 32 * th + r32) * D + g * 64, acc0, acc1, 1.0f, ssq + (32 * th + r32) * 4 + 0, lane);
    }
    __syncthreads();
#pragma unroll 1
    for (int it = 0; it < 3; ++it) {
        const int idx = wave + 8 * it;
        if (idx < 12) chunk_item(H, Yraw, lds, b, chunk, idx >> 1, idx & 1, wave, lane);
        else sb_item(H, Yraw, lds, b, chunk, (idx - 12) >> 1, (idx - 12) & 1, wave, lane);
    }
    VM_WAIT(); __syncthreads();
#pragma unroll 1
    for (int i = 0; i < 8; ++i) {
        const int tt = wave * 8 + i;
        const float r0 = 1.0f / sqrtf(ssq[tt * 4 + 0] * (1.0f / 256.f) + RMS_EPS), r1 = 1.0f / sqrtf(ssq[tt * 4 + 1] * (1.0f / 384.f) + RMS_EPS), r2 = 1.0f / sqrtf(ssq[tt * 4 + 2] * (1.0f / 384.f) + RMS_EPS);
#pragma unroll
        for (int j = 0; j < 4; ++j) { const int col = 4 * lane + 256 * j;
            const f32x4 v = *(const GAS f32x4*)(Yraw + (row0 + tt) * D + col), gm = *(const GAS f32x4*)(g_mix + col);
            const float rr = col < 256 ? r0 : (col < 640 ? r1 : r2);
            v2u w; w.x = cvtpk(v[0] * rr * gm[0], v[1] * rr * gm[1]); w.y = cvtpk(v[2] * rr * gm[2], v[3] * rr * gm[3]);
            *(GAS v2u*)(Yb + (row0 + tt) * D + col) = w; }
    }
    __syncthreads();
}
struct Args { const float* in[18]; float* out; unsigned char* ws; int ph_lo, ph_hi; };
enum { I_X = 0, I_WIN, I_POOLW, I_POOLS, I_RELB, I_GMIX, I_WOUT, I_LN1G, I_LN1B, I_LN2G, I_LN2B, I_FWG, I_FWU, I_FWD, I_ROUTER, I_MWG, I_MWU, I_MWD };

__device__ __forceinline__ void p0_transpose_item(const float* __restrict__ W, int K, int N, bf16* __restrict__ WT, int kind, LAS float* scr, int item, int lane) {
    const int nblk = N / 32, kb = item / nblk, nb = item % nblk, k0 = 64 * kb, n0 = 32 * nb;
#pragma unroll 8
    for (int i = 0; i < 32; ++i) { const int kk = 2 * i + (lane >> 5); scr[kk * 33 + (lane & 31)] = W[(size_t)(k0 + kk) * N + n0 + (lane & 31)]; }
    LDS_WAIT(); asm volatile("" ::: "memory");
    const int drow0 = kind == 0 ? n0 : (256 * (n0 >> 7) + (n0 & 127) + (kind == 2 ? 128 : 0));
    const int c = lane & 7;
#pragma unroll
    for (int j = 0; j < 4; ++j) { const int n = (lane >> 3) + 8 * j; const LAS float* s = scr + (8 * c) * 33 + n;
        v4u o; o.x = pk2(s[0 * 33], s[1 * 33]); o.y = pk2(s[2 * 33], s[3 * 33]); o.z = pk2(s[4 * 33], s[5 * 33]); o.w = pk2(s[6 * 33], s[7 * 33]);
        *(GAS v4u*)(WT + (size_t)(drow0 + n) * K + k0 + 8 * c) = o; }
    LDS_WAIT(); asm volatile("" ::: "memory");
}
__device__ __forceinline__ void ph_prologue(const Args& a, LAS unsigned char* lds, int gw, int NGW, int wave, int lane) {
    LAS float* scr = (LAS float*)(lds + wave * 16384);
    unsigned char* ws = a.ws;
    constexpr int I_IN = (D / 64) * (DIN / 32), I_OUT = (D / 64) * (D / 32), I_F = (D / 64) * (DFF / 32);
    static_assert((DFF / 64) * (D / 32) == I_F, "item counts");
    constexpr int NITEMS = 2 * I_IN + 2 * I_OUT + 27 * I_F;
    for (int it = gw; it < NITEMS; it += NGW) {
        int r = it;
        if (r < 2 * I_IN) { const int L = r / I_IN; p0_transpose_item(a.in[I_WIN] + (size_t)L * D * DIN, D, DIN, (bf16*)(ws + WS_WIN) + (size_t)L * DIN * D, 0, scr, r % I_IN, lane); continue; }
        r -= 2 * I_IN;
        if (r < 2 * I_OUT) { const int L = r / I_OUT; p0_transpose_item(a.in[I_WOUT] + (size_t)L * D * D, D, D, (bf16*)(ws + WS_WOUT) + (size_t)L * D * D, 0, scr, r % I_OUT, lane); continue; }
        r -= 2 * I_OUT;
        const int mi = r / I_F, item = r % I_F, kind = mi % 3, grp = mi / 3;
        if (grp == 0) {
            if (kind == 0) p0_transpose_item(a.in[I_FWG], D, DFF, (bf16*)(ws + WS_WGU), 1, scr, item, lane);
            else if (kind == 1) p0_transpose_item(a.in[I_FWU], D, DFF, (bf16*)(ws + WS_WGU), 2, scr, item, lane);
            else p0_transpose_item(a.in[I_FWD], DFF, D, (bf16*)(ws + WS_WD), 0, scr, item, lane);
        } else {
            const int e = grp - 1;
            if (kind == 0) p0_transpose_item(a.in[I_MWG] + (size_t)e * D * DFF, D, DFF, (bf16*)(ws + WS_MWGU) + (size_t)e * 2 * DFF * D, 1, scr, item, lane);
            else if (kind == 1) p0_transpose_item(a.in[I_MWU] + (size_t)e * D * DFF, D, DFF, (bf16*)(ws + WS_MWGU) + (size_t)e * 2 * DFF * D, 2, scr, item, lane);
            else p0_transpose_item(a.in[I_MWD] + (size_t)e * DFF * D, DFF, D, (bf16*)(ws + WS_MWD) + (size_t)e * D * DFF, 0, scr, item, lane);
        }
    }
    const float* x = a.in[I_X]; bf16* xb = (bf16*)(ws + WS_XB);
    for (int m = gw; m < M; m += NGW) {
#pragma unroll
        for (int j = 0; j < 4; ++j) { const int col = 4 * lane + 256 * j; const f32x4 v = *(const f32x4*)(x + (size_t)m * D + col);
            v2u w; w.x = pk2(v[0], v[1]); w.y = pk2(v[2], v[3]); *(v2u*)(xb + (size_t)m * D + col) = w; }
    }
}

template <bool ROUTE>
__device__ __forceinline__ void ph_ln(const float* xi, const float* __restrict__ mf, const float* __restrict__ g, const float* __restrict__ be, float* xo, bf16* __restrict__ xb,
                                      const float* __restrict__ router, int* __restrict__ toke, float* __restrict__ tokw, int* __restrict__ cnt, LAS unsigned char* lds, int v, int G, int tid, int wave, int lane) {
    LAS int* hist = (LAS int*)lds;
    if (ROUTE) { if (tid < 8) hist[tid] = 0; __syncthreads(); }
    f32x4 gv[4], bv[4];
#pragma unroll
    for (int j = 0; j < 4; ++j) { gv[j] = *(const f32x4*)(g + 4 * lane + 256 * j); bv[j] = *(const f32x4*)(be + 4 * lane + 256 * j); }
    for (int blk = v; blk < M / 64; blk += G) {
#pragma unroll 1
        for (int i = 0; i < 8; ++i) {
            const size_t m = (size_t)blk * 64 + wave * 8 + i;
            f32x4 x[4]; float s = 0.f;
#pragma unroll
            for (int j = 0; j < 4; ++j) { const size_t o = m * D + 4 * lane + 256 * j; const f32x4 a = *(const f32x4*)(xi + o), c = *(const f32x4*)(mf + o);
                x[j] = a * ALPHA + c; s += (x[j][0] + x[j][1]) + (x[j][2] + x[j][3]); }
            const float mean = wave_sum(s) * (1.f / D); float q = 0.f;
#pragma unroll
            for (int j = 0; j < 4; ++j) { x[j] = x[j] - mean; q += (x[j][0] * x[j][0] + x[j][1] * x[j][1]) + (x[j][2] * x[j][2] + x[j][3] * x[j][3]); }
            const float rstd = 1.f / sqrtf(wave_sum(q) * (1.f / D) + LN_EPS);
#pragma unroll
            for (int j = 0; j < 4; ++j) { const size_t o = m * D + 4 * lane + 256 * j; x[j] = x[j] * rstd * gv[j] + bv[j];
                *(f32x4*)(xo + o) = x[j]; v2u w; w.x = pk2(x[j][0], x[j][1]); w.y = pk2(x[j][2], x[j][3]); *(v2u*)(xb + o) = w; }
            if (ROUTE) {
                float lg[8];
#pragma unroll
                for (int e = 0; e < 8; ++e) lg[e] = 0.f;
#pragma unroll
                for (int j = 0; j < 4; ++j)
#pragma unroll
                    for (int k = 0; k < 4; ++k) { const float* rw = router + (size_t)(4 * lane + 256 * j + k) * 8; const f32x4 r0 = *(const f32x4*)rw, r1 = *(const f32x4*)(rw + 4);
                        lg[0] += x[j][k] * r0[0]; lg[1] += x[j][k] * r0[1]; lg[2] += x[j][k] * r0[2]; lg[3] += x[j][k] * r0[3];
                        lg[4] += x[j][k] * r1[0]; lg[5] += x[j][k] * r1[1]; lg[6] += x[j][k] * r1[2]; lg[7] += x[j][k] * r1[3]; }
#pragma unroll
                for (int e = 0; e < 8; ++e) lg[e] = wave_sum(lg[e]);
                int i1 = 0; float v1 = lg[0];
#pragma unroll
                for (int e = 1; e < 8; ++e) if (lg[e] > v1) { v1 = lg[e]; i1 = e; }
                int i2 = i1 == 0 ? 1 : 0; float v2 = i1 == 0 ? lg[1] : lg[0];
#pragma unroll
                for (int e = 1; e < 8; ++e) if (e != i1 && lg[e] > v2) { v2 = lg[e]; i2 = e; }
                const float e2 = expf(v2 - v1), w1 = 1.f / (1.f + e2), w2 = e2 / (1.f + e2);
                if (lane == 0) { toke[2 * m] = i1; toke[2 * m + 1] = i2; tokw[2 * m] = w1; tokw[2 * m + 1] = w2;
                    __hip_atomic_fetch_add(hist + i1, 1, __ATOMIC_RELAXED, __HIP_MEMORY_SCOPE_WORKGROUP); __hip_atomic_fetch_add(hist + i2, 1, __ATOMIC_RELAXED, __HIP_MEMORY_SCOPE_WORKGROUP); }
            }
        }
    }
    if (ROUTE) { __syncthreads(); if (tid < 8) cnt[v * 8 + tid] = hist[tid]; __syncthreads(); }
}

__device__ __forceinline__ void moe_offsets(const int* __restrict__ cnt, int v, int lane, int (&offs)[9], int (&before)[8]) {
    int tot[8], bef[8];
#pragma unroll
    for (int e = 0; e < 8; ++e) { tot[e] = 0; bef[e] = 0; }
#pragma unroll
    for (int i = 0; i < 4; ++i) { const int w = 4 * lane + i; const int* p = cnt + w * 8;
#pragma unroll
        for (int e = 0; e < 8; ++e) { const int c = p[e]; tot[e] += c; bef[e] += (w < v) ? c : 0; } }
#pragma unroll
    for (int e = 0; e < 8; ++e) {
#pragma unroll
        for (int o = 1; o < 64; o <<= 1) { tot[e] += __shfl_xor(tot[e], o); bef[e] += __shfl_xor(bef[e], o); } }
    int run = 0;
#pragma unroll
    for (int e = 0; e < 8; ++e) { offs[e] = run; before[e] = bef[e]; run += (tot[e] + 255) & ~255; }
    offs[8] = run;
}
__device__ __forceinline__ void ph_assign(const int* __restrict__ cnt, const int* __restrict__ toke, int* __restrict__ toks, const bf16* __restrict__ xb, bf16* __restrict__ xperm,
                                          LAS unsigned char* lds, int v, int tid, int wave, int lane) {
    LAS int* slotl = (LAS int*)lds;
    if (wave == 0) {
        int offs[9], before[8]; moe_offsets(cnt, v, lane, offs, before);
        const int t = v * 64 + lane, e1 = toke[2 * t], e2 = toke[2 * t + 1];
        int s1 = 0, s2 = 0;
        const unsigned long long lt = (1ull << lane) - 1ull;
#pragma unroll
        for (int e = 0; e < 8; ++e) {
            const unsigned long long m0 = __ballot(e1 == e), m1 = __ballot(e2 == e);
            const int base = offs[e] + before[e];
            if (e1 == e) s1 = base + __popcll(m0 & lt);
            if (e2 == e) s2 = base + __popcll(m0) + __popcll(m1 & lt);
        }
        toks[2 * t] = s1; toks[2 * t + 1] = s2; slotl[2 * lane] = s1; slotl[2 * lane + 1] = s2;
    }
    __syncthreads();
#pragma unroll 1
    for (int i = 0; i < 16; ++i) { const int p = wave * 16 + i, tt = p >> 1; const int slot = slotl[p];
        const bf16* src = xb + (size_t)(v * 64 + tt) * D; bf16* dst = xperm + (size_t)slot * D;
        const v4u a = *(const v4u*)(src + 8 * lane), b = *(const v4u*)(src + 512 + 8 * lane);
        *(v4u*)(dst + 8 * lane) = a; *(v4u*)(dst + 512 + 8 * lane) = b; }
    __syncthreads();
}
__device__ __forceinline__ void ph_combine(const float* xi, const bf16* __restrict__ yperm, const int* __restrict__ toks, const float* __restrict__ tokw, const float* __restrict__ g, const float* __restrict__ be,
                                           float* xo, int gw, int NGW, int lane) {
    f32x4 gv[4], bv[4];
#pragma unroll
    for (int j = 0; j < 4; ++j) { gv[j] = *(const f32x4*)(g + 4 * lane + 256 * j); bv[j] = *(const f32x4*)(be + 4 * lane + 256 * j); }
    for (int m = gw; m < M; m += NGW) {
        const int s1 = toks[2 * m], s2 = toks[2 * m + 1]; const float w1 = tokw[2 * m], w2 = tokw[2 * m + 1];
        f32x4 x[4]; float s = 0.f;
#pragma unroll
        for (int j = 0; j < 4; ++j) { const int col = 4 * lane + 256 * j; const f32x4 a = *(const f32x4*)(xi + (size_t)m * D + col);
            const v2u y1 = *(const v2u*)(yperm + (size_t)s1 * D + col), y2 = *(const v2u*)(yperm + (size_t)s2 * D + col);
            x[j][0] = a[0] * ALPHA + w1 * bflo(y1.x) + w2 * bflo(y2.x); x[j][1] = a[1] * ALPHA + w1 * bfhi(y1.x) + w2 * bfhi(y2.x);
            x[j][2] = a[2] * ALPHA + w1 * bflo(y1.y) + w2 * bflo(y2.y); x[j][3] = a[3] * ALPHA + w1 * bfhi(y1.y) + w2 * bfhi(y2.y);
            s += (x[j][0] + x[j][1]) + (x[j][2] + x[j][3]); }
        const float mean = wave_sum(s) * (1.f / D); float q = 0.f;
#pragma unroll
        for (int j = 0; j < 4; ++j) { x[j] = x[j] - mean; q += (x[j][0] * x[j][0] + x[j][1] * x[j][1]) + (x[j][2] * x[j][2] + x[j][3] * x[j][3]); }
        const float rstd = 1.f / sqrtf(wave_sum(q) * (1.f / D) + LN_EPS);
#pragma unroll
        for (int j = 0; j < 4; ++j) *(f32x4*)(xo + (size_t)m * D + 4 * lane + 256 * j) = x[j] * rstd * gv[j] + bv[j];
    }
}
constexpr int N_PHASES = 16;
__global__ void __launch_bounds__(NWAVES * 64, 2) mk_fwd(Args a) {
    extern __shared__ __attribute__((aligned(16))) unsigned char lds_raw[];
    LAS unsigned char* lds = (LAS unsigned char*)lds_raw;
    const int tid = threadIdx.x, lane = tid & 63, wave = __builtin_amdgcn_readfirstlane(tid >> 6);
    const int G = gridDim.x, bx = blockIdx.x;
    const int vcu = (G % 8 == 0) ? (bx % 8) * (G / 8) + bx / 8 : bx;
    const int gw = vcu * NWAVES + wave, NGW = G * NWAVES;
    unsigned char* ws = a.ws;
    gu32* ctl = (gu32*)(ws + WS_CTL);
    for (int u = tid; u < (LDS_BYTES - LDSCTL_OFF) / 4; u += NWAVES * 64) ((LAS unsigned*)(lds + LDSCTL_OFF))[u] = 0u;
    __syncthreads();
    const int lo = a.ph_lo, hi = a.ph_hi;
    XcdBarrier bar; bar.bar = (unsigned*)(ctl + CW_BAR); bar.x = 0; bar.st = nullptr;
    if (hi - lo > 1) bar = xcd_barrier_post((unsigned*)(ctl + CW_BAR), (volatile LAS unsigned*)(lds + MISC_OFF) + 8);
#define IN(k) (lo <= (k) && (k) < hi)
#define SEAM(k) do { if (IN(k) && IN((k) + 1)) xcd_barrier(bar); } while (0)
    bf16* const XB = (bf16*)(ws + WS_XB); bf16* const HB = (bf16*)(ws + WS_HB); bf16* const YB = (bf16*)(ws + WS_YB); float* const MF = (float*)(ws + WS_MF);
    float* const X = a.out;
    int* const toke = (int*)(ws + WS_TOKE); float* const tokw = (float*)(ws + WS_TOKW); int* const toks = (int*)(ws + WS_TOKS); int* const cnt = (int*)(ws + WS_CNT);

    if (IN(0)) { ph_prologue(a, lds, gw, NGW, wave, lane); SEAM(0); }

#define LAYER_BODY(L) do { \
        const int pb = 1 + 7 * L; \
          \
        if (IN(pb)) { \
            pg8::Gemm g{XB, (const pg8::bf16_t*)(ws + WS_WIN) + (size_t)L * DIN * D, M, DIN, D}; pg8::StaticOrder S; S.init(M, DIN, G, bx); \
            pg8::EpiStoreBf16P E{HB, DIN, DIN / 256}; \
            pg8::gemm_phase<pg8::EpiStoreBf16P, pg8::StaticOrder, PG8_ALIGN, PG8_SP2>(lds + RING_OFF, g, S, E); \
            SEAM(pb); \
        } \
          \
        if (IN(pb + 1)) { \
            { const int u = vcu;   \
                mixer_unit(lds, (const GAS bf16*)HB, (GAS float*)MF, (GAS bf16*)YB, (const GAS float*)(a.in[I_POOLW] + L * 4 * 64 * 64), (const GAS float*)(a.in[I_POOLS] + L * 256), (const GAS float*)(a.in[I_RELB] + L * 6 * 257), (const GAS float*)(a.in[I_GMIX] + L * D), u >> 6, u & 63, tid, wave, lane); } \
            SEAM(pb + 1); \
        } \
          \
        if (IN(pb + 2)) { \
            pg8::Gemm g{YB, (const pg8::bf16_t*)(ws + WS_WOUT) + (size_t)L * D * D, M, D, D}; pg8::StaticOrder S; S.init(M, D, G, bx); \
            pg8::EpiF32 E{MF, D, 0}; \
            pg8::gemm_phase<pg8::EpiF32, pg8::StaticOrder, PG8_ALIGN, PG8_SP2>(lds + RING_OFF, g, S, E); \
            SEAM(pb + 2); \
        } \
          \
        if (IN(pb + 3)) { \
            const float* xi = L == 0 ? a.in[I_X] : X; \
            if (L == 0) ph_ln<false>(xi, MF, a.in[I_LN1G] + L * D, a.in[I_LN1B] + L * D, X, XB, nullptr, nullptr, nullptr, nullptr, lds, vcu, G, tid, wave, lane); \
            else ph_ln<true>(xi, MF, a.in[I_LN1G] + L * D, a.in[I_LN1B] + L * D, X, XB, a.in[I_ROUTER], toke, tokw, cnt, lds, vcu, G, tid, wave, lane); \
            SEAM(pb + 3); \
        } \
        if (L == 0) { \
            if (IN(5)) {     \
                pg8::Gemm g{XB, (const pg8::bf16_t*)(ws + WS_WGU), M, 2 * DFF, D}; pg8::StaticOrder S; S.init(M, 2 * DFF, G, bx); \
                pg8::EpiSwiGLU E{HB, DFF, 2 * DFF / 256}; \
                pg8::gemm_phase<pg8::EpiSwiGLU, pg8::StaticOrder, PG8_ALIGN, PG8_SP2>(lds + RING_OFF, g, S, E); \
                SEAM(5); \
            } \
            if (IN(6)) {     \
                pg8::Gemm g{HB, (const pg8::bf16_t*)(ws + WS_WD), M, D, DFF}; pg8::StaticOrder S; S.init(M, D, G, bx); \
                pg8::EpiF32 E{MF, D, 0}; \
                pg8::gemm_phase<pg8::EpiF32, pg8::StaticOrder, PG8_ALIGN, PG8_SP2>(lds + RING_OFF, g, S, E); \
                SEAM(6); \
            } \
            if (IN(7)) { ph_ln<false>(X, MF, a.in[I_LN2G], a.in[I_LN2B], X, XB, nullptr, nullptr, nullptr, nullptr, lds, vcu, G, tid, wave, lane); SEAM(7); } \
        } else { \
            if (IN(12)) { ph_assign(cnt, toke, toks, XB, (bf16*)(ws + WS_XPERM), lds, vcu, tid, wave, lane); SEAM(12); } \
            if (IN(13) || IN(14)) { \
                int offs[9], before[8]; moe_offsets(cnt, 0, lane, offs, before); \
                pg8::GroupedOrder S; \
_Pragma("unroll") for (int e = 0; e < 9; ++e) S.ts[e] = __builtin_amdgcn_readfirstlane(offs[e]) >> 8; \
                const int nT = S.ts[8]; \
                if (IN(13)) {     \
                    S.npn = 2 * DFF / 256; S.so.init(nT * 256, 2 * DFF, G, bx); \
                    pg8::Gemm g{(const pg8::bf16_t*)(ws + WS_XPERM), (const pg8::bf16_t*)(ws + WS_MWGU), nT * 256, 2 * DFF, D}; \
                    pg8::EpiSwiGLU E{(pg8::bf16_t*)(ws + WS_HPERM), DFF, 2 * DFF / 256}; \
                    pg8::gemm_phase<pg8::EpiSwiGLU, pg8::GroupedOrder, PG8_ALIGN, PG8_SP2>(lds + RING_OFF, g, S, E); \
                    SEAM(13); \
                } \
                if (IN(14)) {     \
                    S.npn = D / 256; S.so.init(nT * 256, D, G, bx); \
                    pg8::Gemm g{(const pg8::bf16_t*)(ws + WS_HPERM), (const pg8::bf16_t*)(ws + WS_MWD), nT * 256, D, DFF}; \
                    pg8::EpiStoreBf16P E{(pg8::bf16_t*)(ws + WS_YPERM), D, D / 256}; \
                    pg8::gemm_phase<pg8::EpiStoreBf16P, pg8::GroupedOrder, PG8_ALIGN, PG8_SP2>(lds + RING_OFF, g, S, E); \
                    SEAM(14); \
                } \
            } \
            if (IN(15)) ph_combine(X, (const bf16*)(ws + WS_YPERM), toks, tokw, a.in[I_LN2G] + D, a.in[I_LN2B] + D, X, gw, NGW, lane); \
        } \
    } while (0)
    LAYER_BODY(0);
    LAYER_BODY(1);
#undef LAYER_BODY
#undef IN
#undef SEAM
}
#ifndef DEV_MASK
#define DEV_MASK 0x3f
#endif
#ifndef ONE_LAUNCH
#define ONE_LAUNCH 1
#endif
static void launch_mk(Args a, int lo, int hi, int grid, hipStream_t s) { a.ph_lo = lo; a.ph_hi = hi; hipLaunchKernelGGL(mk_fwd, dim3(grid), dim3(NWAVES * 64), LDS_BYTES, s, a); }

extern "C" void kernel_launch(void* const* d_in, const int* in_sizes, int n_in, void* d_out, int out_size, void* d_ws, size_t ws_size, hipStream_t stream) {
    static int grid = 0;
    if (grid == 0) {
        if (n_in != 18 || in_sizes[0] != M * D || out_size != M * D || ws_size < WS_END) { fprintf(stderr, "kernel_launch: unexpected shapes / workspace (%d inputs, ws %zu < %zu)\n", n_in, ws_size, (size_t)WS_END); grid = -1; return; }
        int dev = 0, cus = 0, per_cu = 0;
        if (hipGetDevice(&dev) != hipSuccess || hipDeviceGetAttribute(&cus, hipDeviceAttributeMultiprocessorCount, dev) != hipSuccess) { grid = -1; return; }
        if (hipFuncSetAttribute((const void*)mk_fwd, hipFuncAttributeMaxDynamicSharedMemorySize, LDS_BYTES) != hipSuccess) { fprintf(stderr, "kernel_launch: hipFuncSetAttribute failed\n"); grid = -1; return; }
        if (hipOccupancyMaxActiveBlocksPerMultiprocessor(&per_cu, (const void*)mk_fwd, NWAVES * 64, LDS_BYTES) != hipSuccess || per_cu < 1) { fprintf(stderr, "kernel_launch: occupancy query says %d blocks per CU\n", per_cu); }
        (void)hipGetLastError();
        grid = cus;
        if (grid != 256) { fprintf(stderr, "kernel_launch: built for 256 CUs, device has %d\n", cus); grid = -1; return; }
    }
    if (grid < 0) return;
    (void)hipMemsetAsync((char*)d_ws + WS_CTL, 0, CTL_ZERO_BYTES, stream);
    Args a{};
    for (int i = 0; i < 18; ++i) a.in[i] = (const float*)d_in[i];
    a.out = (float*)d_out; a.ws = (unsigned char*)d_ws;
#if ONE_LAUNCH
    launch_mk(a, 0, N_PHASES, grid, stream);
#elif defined(PROBE_DUP)
    for (int p = 0; p < N_PHASES; ++p) { launch_mk(a, p, p + 1, grid, stream); if ((PROBE_DUP >> p) & 1) launch_mk(a, p, p + 1, grid, stream); }
#else
    unsigned char* ws = (unsigned char*)d_ws;
    float* X = (float*)d_out; bf16* Xb = (bf16*)(ws + WS_XB); bf16* H = (bf16*)(ws + WS_HB); bf16* Yb = (bf16*)(ws + WS_YB); float* Mf = (float*)(ws + WS_MF);
    float* pooled = (float*)(ws + WS_YB); float* gates = (float*)(ws + WS_GATES);
    const float* x = a.in[I_X];
    launch_mk(a, 0, 1, grid, stream);
    for (int L = 0; L < 2; ++L) {
        const int pb = 1 + 7 * L;
        if (DEV_MASK & 1) launch_mk(a, pb, pb + 1, grid, stream);
        else gemm_simple<false, EpiStoreBf16><<<dim3(DIN / 128, M / 128), 256, 0, stream>>>(Xb, D, a.in[I_WIN] + (size_t)L * D * DIN, nullptr, DIN, D, EpiStoreBf16{H, DIN, 0});
        if (DEV_MASK & 2) launch_mk(a, pb + 1, pb + 2, grid, stream);
        else {
            pool_a<<<M * 256 / 256, 256, 0, stream>>>(H, pooled);
            pool_b<<<M * 256 / 256, 256, 0, stream>>>(pooled, a.in[I_POOLW] + L * 4 * 64 * 64, a.in[I_POOLS] + L * 256, Mf);
            chunk_attn_naive<<<M * 6 / 4, 256, 0, stream>>>(H, a.in[I_RELB] + L * 6 * 257, Mf);
            sb_attn_naive<<<M * 6 / 4, 256, 0, stream>>>(H, Mf);
            rms_cat<<<M / 4, 256, 0, stream>>>(Mf, a.in[I_GMIX] + L * D, Yb);
        }
        if (DEV_MASK & 4) launch_mk(a, pb + 2, pb + 3, grid, stream);
        else gemm_simple<false, EpiStoreF32><<<dim3(D / 128, M / 128), 256, 0, stream>>>(Yb, D, a.in[I_WOUT] + (size_t)L * D * D, nullptr, D, D, EpiStoreF32{Mf, D, 0});
        const bool mk_moe = (DEV_MASK & 32) != 0;
        if ((L == 0 && (DEV_MASK & 8)) || (L == 1 && mk_moe)) launch_mk(a, pb + 3, pb + 4, grid, stream);
        else ln_res<<<M / 4, 256, 0, stream>>>(L == 0 ? x : X, Mf, a.in[I_LN1G] + L * D, a.in[I_LN1B] + L * D, X, Xb);
        if (L == 0) {
            if (DEV_MASK & 16) { launch_mk(a, 5, 6, grid, stream); launch_mk(a, 6, 7, grid, stream); }
            else {
                gemm_simple<true, EpiSwiglu><<<dim3(DFF / 128, M / 128), 256, 0, stream>>>(Xb, D, a.in[I_FWG], a.in[I_FWU], DFF, D, EpiSwiglu{H, DFF, 0});
                gemm_simple<false, EpiStoreF32><<<dim3(D / 128, M / 128), 256, 0, stream>>>(H, DFF, a.in[I_FWD], nullptr, D, DFF, EpiStoreF32{Mf, D, 0});
            }
            if (DEV_MASK & 8) launch_mk(a, 7, 8, grid, stream);
            else ln_res<<<M / 4, 256, 0, stream>>>(X, Mf, a.in[I_LN2G], a.in[I_LN2B], X, Xb);
        } else if (mk_moe) {
            for (int p = 12; p < 16; ++p) launch_mk(a, p, p + 1, grid, stream);
        } else {
            router_naive<<<M / 4, 256, 0, stream>>>(X, a.in[I_ROUTER], gates);
            for (int e = 0; e < NEXP; ++e) {
                gemm_simple<true, EpiSwiglu><<<dim3(DFF / 128, M / 128), 256, 0, stream>>>(Xb, D, a.in[I_MWG] + (size_t)e * D * DFF, a.in[I_MWU] + (size_t)e * D * DFF, DFF, D, EpiSwiglu{H, DFF, 0});
                gemm_simple<false, EpiMoeAcc><<<dim3(D / 128, M / 128), 256, 0, stream>>>(H, DFF, a.in[I_MWD] + (size_t)e * DFF * D, nullptr, D, DFF, EpiMoeAcc{Mf, gates, e, 0});
            }
            ln_res<<<M / 4, 256, 0, stream>>>(X, Mf, a.in[I_LN2G] + D, a.in[I_LN2B] + D, X, Xb);
        }
    }
#endif
}
```
